# Optimizing an MI355X kernel written in HIP

```python
import math
import jax, jax.numpy as jnp
from jax import lax
import numpy as np


D_MODEL = 1024
BATCH = 2
SEQ = 8192
DEPTH = 4
DEC_BATCH = 128
DEC_SEQ = 8
PAST_LEN = 8192
PAGE_SIZE = 128

MIX_WIDTH = D_MODEL
A_WIDTH = MIX_WIDTH // 4
A_HEADS = 4
A_HEAD_DIM = A_WIDTH // A_HEADS
A_CHUNK = 128
B_WIDTH = MIX_WIDTH // 4
B_CONV = 31
C_HEADS = 4
C_KV_HEADS = 2
C_GROUP = C_HEADS // C_KV_HEADS
C_HEAD_DIM = MIX_WIDTH // 16
C_WIDTH = C_HEADS * C_HEAD_DIM
C_KV_WIDTH = C_KV_HEADS * C_HEAD_DIM
WINDOW = 128
C_BLOCK = WINDOW
D_WIDTH = MIX_WIDTH - A_WIDTH - B_WIDTH - C_WIDTH
D_HEAD_DIM = 64
D_HEADS = D_WIDTH // D_HEAD_DIM
D_GROUPS = 2
D_STATE = 128
D_CONV = 4
D_CHUNK = 128
D_CONV_DIM = D_WIDTH + 2 * D_GROUPS * D_STATE
IN_DIM = 3 * A_WIDTH + 3 * B_WIDTH + (2 * C_WIDTH + 2 * C_KV_WIDTH) + (D_WIDTH + D_CONV_DIM + D_HEADS)
EPS = 1e-6

kernel_name = 'hybrid_parallel_groups_decode_step'


def rms_norm(x, g):
    xf = x.astype(jnp.float32)
    y = xf * lax.rsqrt(jnp.mean(xf * xf, axis=-1, keepdims=True) + EPS)
    return (y * g.astype(jnp.float32)).astype(x.dtype)


def layer_norm(x, g, b):
    xf = x.astype(jnp.float32)
    mu = jnp.mean(xf, axis=-1, keepdims=True)
    xc = xf - mu
    y = xc * lax.rsqrt(jnp.mean(xc * xc, axis=-1, keepdims=True) + EPS)
    return (y * g.astype(jnp.float32) + b.astype(jnp.float32)).astype(x.dtype)


def causal_dwconv(x_hist, w, b):
    c = x_hist.shape[-1]
    y = lax.conv_general_dilated(x_hist.astype(w.dtype), w[:, None, :], window_strides=(1,),
                                 padding='VALID', dimension_numbers=('NWC', 'WIO', 'NWC'),
                                 feature_group_count=c)
    return y + b


def alibi_slopes(n):
    return jnp.asarray(2.0 ** (-8.0 * np.arange(1, n + 1) / n), dtype=jnp.float32)


def split_in(proj):
    sizes = [A_WIDTH] * 3 + [B_WIDTH] * 3 + [C_WIDTH, C_KV_WIDTH, C_KV_WIDTH, C_WIDTH] + [D_WIDTH, D_CONV_DIM, D_HEADS]
    offs = [int(o) for o in np.cumsum(sizes)[:-1]]
    return jnp.split(proj, offs, axis=-1)


def mixer_a(u_raw, v_raw, ln_g, ln_b, ws, wb):
    n, l, _ = u_raw.shape
    q = min(l, A_CHUNK)
    u = jax.nn.gelu(u_raw)
    v = layer_norm(jax.nn.gelu(v_raw), ln_g, ln_b)
    vc = v.reshape(n, l // q, q, A_HEADS, A_HEAD_DIM)
    tri = jnp.tril(jnp.ones((q, q), dtype=bool))
    wm = jnp.where(tri, ws[:, :q, :q], 0.0)
    s = jnp.einsum('hts,bcshd->bcthd', wm, vc) + wb[:, :q].T[:, :, None]
    return u * s.reshape(n, l, A_WIDTH), v


def mixer_b(bv, bg, hist, conv_w, conv_b, ln_g, ln_b, pw_w, pw_b, prompt):
    glu = bv * jax.nn.sigmoid(bg)
    c = causal_dwconv(jnp.concatenate([hist, glu], axis=1), conv_w, conv_b)
    y = jax.nn.silu(layer_norm(c, ln_g, ln_b)) @ pw_w + pw_b
    new_rows = glu[:, -(B_CONV - 1):] if prompt else glu
    return y, new_rows


def sink_attention(qb, kb, vb, rel, valid, sinks):
    slopes = alibi_slopes(C_HEADS).reshape(C_KV_HEADS, C_GROUP)[:, :, None, None]
    s = jnp.einsum('bnqkgd,bnskd->bnkgqs', qb, kb).astype(jnp.float32)
    s = s - slopes * rel.astype(jnp.float32)
    s = jnp.where(valid[:, None, None], s, -jnp.inf)
    sink = sinks.astype(jnp.float32).reshape(C_KV_HEADS, C_GROUP)[:, :, None, None]
    m = jnp.maximum(jnp.max(s, axis=-1, keepdims=True), sink)
    p = jnp.exp(s - m)
    denom = jnp.sum(p, axis=-1, keepdims=True) + jnp.exp(sink - m)
    return jnp.einsum('bnkgqs,bnskd->bnqkgd', (p / denom).astype(vb.dtype), vb)


def mixer_c(q, k, v, k_past, v_past, sinks, prompt):
    n, l, _ = q.shape
    qh = q.reshape(n, l, C_KV_HEADS, C_GROUP, C_HEAD_DIM) * (C_HEAD_DIM ** -0.5)
    kh = k.reshape(n, l, C_KV_HEADS, C_HEAD_DIM)
    vh = v.reshape(n, l, C_KV_HEADS, C_HEAD_DIM)
    if prompt:
        nb = l // C_BLOCK
        pad = jnp.zeros((n, C_BLOCK, C_KV_HEADS, C_HEAD_DIM), kh.dtype)
        kp = jnp.concatenate([pad, kh], axis=1).reshape(n, nb + 1, C_BLOCK, C_KV_HEADS, C_HEAD_DIM)
        vp = jnp.concatenate([pad, vh], axis=1).reshape(n, nb + 1, C_BLOCK, C_KV_HEADS, C_HEAD_DIM)
        kb = jnp.concatenate([kp[:, :-1], kp[:, 1:]], axis=2)
        vb = jnp.concatenate([vp[:, :-1], vp[:, 1:]], axis=2)
        qb = qh.reshape(n, nb, C_BLOCK, C_KV_HEADS, C_GROUP, C_HEAD_DIM)
        si = jnp.arange(2 * C_BLOCK)
        rel = jnp.arange(C_BLOCK)[:, None] + C_BLOCK - si[None, :]
        key_pos = (jnp.arange(nb) * C_BLOCK - C_BLOCK)[:, None, None] + si[None, None, :]
        valid = (rel >= 0) & (rel <= WINDOW) & (key_pos >= 0)
        keep = min(WINDOW, l)
        k_new, v_new = kh[:, l - keep:], vh[:, l - keep:]
    else:
        past = k_past.shape[1]
        kb = jnp.concatenate([k_past, kh], axis=1)[:, None]
        vb = jnp.concatenate([v_past, vh], axis=1)[:, None]
        qb = qh[:, None]
        rel = jnp.arange(l)[:, None] + past - jnp.arange(past + l)[None, :]
        valid = ((rel >= 0) & (rel <= WINDOW))[None]
        k_new, v_new = kh, vh
    o = sink_attention(qb, kb, vb, rel, valid, sinks)
    return o.reshape(n, l, C_WIDTH), k_new, v_new


def ssd(x, dt, a, bm, cm, h0, chunk):
    n, l, h, p = x.shape
    nc = l // chunk
    f32 = jnp.float32
    xc = x.astype(f32).reshape(n, nc, chunk, h, p)
    dtc = dt.astype(f32).reshape(n, nc, chunk, h)
    bc = bm.astype(f32).reshape(n, nc, chunk, h, -1)
    cc = cm.astype(f32).reshape(n, nc, chunk, h, -1)
    acum = jnp.cumsum(dtc * a, axis=2)
    seg = acum[:, :, :, None, :] - acum[:, :, None, :, :]
    tri = jnp.tril(jnp.ones((chunk, chunk), dtype=bool))[:, :, None]
    decay = jnp.exp(jnp.where(tri, seg, -jnp.inf))
    scores = jnp.einsum('bcthn,bcshn->bctsh', cc, bc) * decay
    y_intra = jnp.einsum('bctsh,bcsh,bcshp->bcthp', scores, dtc, xc)
    decay_end = jnp.exp(acum[:, :, -1:, :] - acum)
    states = jnp.einsum('bcsh,bcsh,bcshn,bcshp->bchpn', decay_end, dtc, bc, xc)
    chunk_decay = jnp.exp(acum[:, :, -1, :])

    def step(h_prev, inp):
        st, cd = inp
        return h_prev * cd[:, :, None, None] + st, h_prev

    h_final, h_in = lax.scan(step, h0.astype(f32),
                             (jnp.moveaxis(states, 1, 0), jnp.moveaxis(chunk_decay, 1, 0)))
    h_in = jnp.moveaxis(h_in, 0, 1)
    y_inter = jnp.einsum('bcthn,bchpn->bcthp', cc, h_in) * jnp.exp(acum)[..., None]
    y = (y_intra + y_inter).reshape(n, l, h, p).astype(x.dtype)
    return y, h_final.astype(h0.dtype)


def mixer_d(z, xbc_raw, dt_raw, hist, h0, conv_w, conv_b, dt_bias, a_log, d_skip, norm_g, prompt):
    n, l, _ = z.shape
    xbc = jax.nn.silu(causal_dwconv(jnp.concatenate([hist, xbc_raw], axis=1), conv_w, conv_b))
    xs, bm, cm = jnp.split(xbc, [D_WIDTH, D_WIDTH + D_GROUPS * D_STATE], axis=-1)
    xs = xs.reshape(n, l, D_HEADS, D_HEAD_DIM)
    rep = D_HEADS // D_GROUPS
    bm = jnp.repeat(bm.reshape(n, l, D_GROUPS, D_STATE), rep, axis=2)
    cm = jnp.repeat(cm.reshape(n, l, D_GROUPS, D_STATE), rep, axis=2)
    dt = jax.nn.softplus(dt_raw.astype(jnp.float32) + dt_bias.astype(jnp.float32))
    a = -jnp.exp(a_log.astype(jnp.float32))
    y, h_new = ssd(xs, dt, a, bm, cm, h0, min(l, D_CHUNK))
    y = (y + d_skip[:, None] * xs).reshape(n, l, D_WIDTH) * jax.nn.silu(z)
    y = rms_norm(y.reshape(n, l, D_GROUPS, D_WIDTH // D_GROUPS),
                 norm_g.reshape(D_GROUPS, D_WIDTH // D_GROUPS)).reshape(n, l, D_WIDTH)
    new_rows = xbc_raw[:, -(D_CONV - 1):] if prompt else xbc_raw
    return y, new_rows, h_new


def layer(x, past, w, prompt):
    (g_pre, g_post, w_in, w_out, a_ln_g, a_ln_b, a_ws, a_wb, b_conv_w, b_conv_b, b_ln_g, b_ln_b,
     b_pw_w, b_pw_b, c_sinks, d_conv_w, d_conv_b, d_dt_bias, d_a_log, d_skip, d_norm_g) = w
    n, l, _ = x.shape
    h = rms_norm(x, g_pre)
    (a_u, a_v, a_z, b_v, b_g, b_z, c_q, c_k, c_v, c_z, d_z, d_xbc, d_dt) = split_in(h @ w_in)
    if prompt:
        k_past = v_past = None
        cb_past = jnp.zeros((n, B_CONV - 1, B_WIDTH), x.dtype)
        cd_past = jnp.zeros((n, D_CONV - 1, D_CONV_DIM), x.dtype)
        ssm_past = jnp.zeros((n, D_HEADS, D_HEAD_DIM, D_STATE), x.dtype)
    else:
        k_past, v_past, cb_past, cd_past, ssm_past = past
    ya, v_rows = mixer_a(a_u, a_v, a_ln_g, a_ln_b, a_ws, a_wb)
    yb, cb_new = mixer_b(b_v, b_g, cb_past, b_conv_w, b_conv_b, b_ln_g, b_ln_b, b_pw_w, b_pw_b, prompt)
    yc, k_new, v_new = mixer_c(c_q, c_k, c_v, k_past, v_past, c_sinks, prompt)
    yd, cd_new, ssm_new = mixer_d(d_z, d_xbc, d_dt, cd_past, ssm_past, d_conv_w, d_conv_b,
                                  d_dt_bias, d_a_log, d_skip, d_norm_g, prompt)
    mixed = jnp.concatenate([ya * jax.nn.silu(a_z), yb * jax.nn.silu(b_z),
                             yc * jax.nn.silu(c_z), yd], axis=-1) @ w_out
    return x + rms_norm(mixed, g_post), (k_new, v_new, cb_new, cd_new, ssm_new, v_rows)


def setup_inputs(seed: int = 0) -> dict:
    key = jax.random.key(seed)
    ks = jax.random.split(key, 32)

    def nrm(k, shape, scale):
        return jax.random.normal(k, shape, jnp.float32) * scale

    win_buf = min(WINDOW, PAST_LEN)
    dt0 = jnp.exp(jax.random.uniform(ks[24], (DEPTH, D_HEADS), jnp.float32, math.log(1e-3), math.log(1e-1)))
    return {
        'x_prompt': nrm(ks[0], (BATCH, SEQ, D_MODEL), 1.0),
        'x_sample': nrm(ks[1], (DEC_BATCH, DEC_SEQ, D_MODEL), 1.0),
        'cache_win_k': nrm(ks[2], (DEPTH, DEC_BATCH, win_buf, C_KV_HEADS, C_HEAD_DIM), 1.0),
        'cache_win_v': nrm(ks[3], (DEPTH, DEC_BATCH, win_buf, C_KV_HEADS, C_HEAD_DIM), 1.0),
        'state_conv_b': nrm(ks[4], (DEPTH, DEC_BATCH, B_CONV - 1, B_WIDTH), 0.5),
        'state_conv_d': nrm(ks[5], (DEPTH, DEC_BATCH, D_CONV - 1, D_CONV_DIM), 1.0),
        'state_ssm': nrm(ks[6], (DEPTH, DEC_BATCH, D_HEADS, D_HEAD_DIM, D_STATE), 0.5),
        'norm_pre': 1.0 + nrm(ks[7], (DEPTH, D_MODEL), 0.02),
        'norm_post': 1.0 + nrm(ks[8], (DEPTH, D_MODEL), 0.02),
        'w_in': nrm(ks[9], (DEPTH, D_MODEL, IN_DIM), D_MODEL ** -0.5),
        'w_out': nrm(ks[10], (DEPTH, MIX_WIDTH, D_MODEL), MIX_WIDTH ** -0.5),
        'a_ln_g': 1.0 + nrm(ks[11], (DEPTH, A_WIDTH), 0.02),
        'a_ln_b': nrm(ks[12], (DEPTH, A_WIDTH), 0.02),
        'a_ws': nrm(ks[13], (DEPTH, A_HEADS, A_CHUNK, A_CHUNK), A_CHUNK ** -0.5),
        'a_wb': 1.0 + nrm(ks[14], (DEPTH, A_HEADS, A_CHUNK), 0.1),
        'b_conv_w': nrm(ks[15], (DEPTH, B_CONV, B_WIDTH), B_CONV ** -0.5),
        'b_conv_b': nrm(ks[16], (DEPTH, B_WIDTH), 0.02),
        'b_ln_g': 1.0 + nrm(ks[17], (DEPTH, B_WIDTH), 0.02),
        'b_ln_b': nrm(ks[18], (DEPTH, B_WIDTH), 0.02),
        'b_pw_w': nrm(ks[19], (DEPTH, B_WIDTH, B_WIDTH), B_WIDTH ** -0.5),
        'b_pw_b': nrm(ks[20], (DEPTH, B_WIDTH), 0.02),
        'c_sinks': nrm(ks[21], (DEPTH, C_HEADS), 1.0),
        'd_conv_w': nrm(ks[22], (DEPTH, D_CONV, D_CONV_DIM), D_CONV ** -0.5),
        'd_conv_b': nrm(ks[23], (DEPTH, D_CONV_DIM), 0.02),
        'd_dt_bias': dt0 + jnp.log(-jnp.expm1(-dt0)),
        'd_a_log': jnp.log(jax.random.uniform(ks[25], (DEPTH, D_HEADS), jnp.float32, 1.0, 16.0)),
        'd_skip': 1.0 + nrm(ks[26], (DEPTH, D_HEADS), 0.1),
        'd_norm_g': 1.0 + nrm(ks[27], (DEPTH, D_WIDTH), 0.02),
    }


def reference(x_prompt, x_sample, cache_win_k, cache_win_v, state_conv_b, state_conv_d, state_ssm,
              norm_pre, norm_post, w_in, w_out, a_ln_g, a_ln_b, a_ws, a_wb, b_conv_w, b_conv_b,
              b_ln_g, b_ln_b, b_pw_w, b_pw_b, c_sinks, d_conv_w, d_conv_b, d_dt_bias, d_a_log,
              d_skip, d_norm_g):
    xp, xs = x_prompt, x_sample
    p_k, p_v, p_cb, p_cd, p_ssm = [], [], [], [], []
    s_k, s_v, s_cb, s_cd, s_ssm, s_av = [], [], [], [], [], []
    for i in range(DEPTH):
        w = (norm_pre[i], norm_post[i], w_in[i], w_out[i], a_ln_g[i], a_ln_b[i], a_ws[i], a_wb[i],
             b_conv_w[i], b_conv_b[i], b_ln_g[i], b_ln_b[i], b_pw_w[i], b_pw_b[i], c_sinks[i],
             d_conv_w[i], d_conv_b[i], d_dt_bias[i], d_a_log[i], d_skip[i], d_norm_g[i])
        xp, (k1, v1, cb1, cd1, ssm1, _) = layer(xp, None, w, True)
        past = (cache_win_k[i], cache_win_v[i], state_conv_b[i], state_conv_d[i], state_ssm[i])
        xs, (k2, v2, cb2, cd2, ssm2, av2) = layer(xs, past, w, False)
        p_k.append(k1); p_v.append(v1); p_cb.append(cb1); p_cd.append(cd1); p_ssm.append(ssm1)
        s_k.append(k2); s_v.append(v2); s_cb.append(cb2); s_cd.append(cd2); s_ssm.append(ssm2); s_av.append(av2)
    return (xp, xs,
            jnp.stack(p_k), jnp.stack(s_k), jnp.stack(p_v), jnp.stack(s_v),
            jnp.stack(p_cb), jnp.stack(s_cb), jnp.stack(p_cd), jnp.stack(s_cd),
            jnp.stack(p_ssm), jnp.stack(s_ssm), jnp.stack(s_av))
```

```cpp
#include <hip/hip_runtime.h>
#include <cstdio>
#include <cstdint>
#include <cstring>
namespace pg8 {
#define PG8_LAS __attribute__((address_space(3)))
typedef unsigned short bf16_t;
typedef short bf16x8 __attribute__((ext_vector_type(8)));
typedef float f32x4 __attribute__((ext_vector_type(4)));
typedef unsigned u32x4 __attribute__((ext_vector_type(4)));
constexpr int BM = 256, BK = 64, HALF = 128, HTB = HALF * BK * 2  , STAGE_BYTES = 8 * HTB, NXCD = 8, WGM = 8;

__host__ __device__ __forceinline__ int lds_byte(int r, int c) { const int st = (r >> 4) * 2 + (c >> 5), rr = r & 15, cc = c & 31, ob = rr * 64 + cc * 2; return st * 1024 + (ob ^ (((ob >> 9) & 1) << 5)); }
__host__ __device__ __forceinline__ void stage_rc(int b, int& R, int& C) { const int st = b / 1024, sb = b % 1024, swz = sb ^ (((sb >> 9) & 1) << 5); R = (st >> 1) * 16 + swz / 64; C = (st & 1) * 32 + (swz % 64) / 2; }
__host__ __device__ __forceinline__ int perm32(int rho) { const int n = rho >> 4, i = rho & 15; return 8 * (i >> 2) + 4 * n + (i & 3); }

struct Unit { int pm, pn; };
struct Gemm { const bf16_t* A; const bf16_t* Bt; int M, N, K; };

struct StaticOrder {
    int nM, nN, nwg, G, c;
    __host__ __device__ void init(int M, int N, int G_, int c_) { nM = M / BM; nN = N / BM; nwg = nM * nN; G = G_; c = c_; }
    __host__ __device__ bool next(int i, Unit& u) const {
        const long L = (long)i * G + c; if (L >= nwg) return false;
        int wgid = (int)L; { const int q = nwg / NXCD, r = nwg % NXCD, xcd = wgid % NXCD, off = wgid / NXCD; wgid = (xcd < r ? xcd * (q + 1) : r * (q + 1) + (xcd - r) * q) + off; }
        const int nig = WGM * nN, gid = wgid / nig, fm = gid * WGM, gsz = (nM - fm) < WGM ? (nM - fm) : WGM;
        u.pm = fm + ((wgid % nig) % gsz); u.pn = (wgid % nig) / gsz; return true;
    }
    __device__ __forceinline__ void a_ready(const Unit&) const {}
    __device__ __forceinline__ void done(const Unit&) const {}
};

__device__ __forceinline__ unsigned cvt_pk_bf16(float lo, float hi) { unsigned r; asm volatile("v_cvt_pk_bf16_f32 %0, %1, %2" : "=v"(r) : "v"(lo), "v"(hi)); return r; }
typedef float f32x2 __attribute__((ext_vector_type(2)));
__device__ __forceinline__ f32x2 gelu_pk(f32x2 v) {
    const f32x2 av = __builtin_elementwise_abs(v), d = av * 0.2316418882f + 1.0f;
    f32x2 t; t.x = __builtin_amdgcn_rcpf(d.x); t.y = __builtin_amdgcn_rcpf(d.y);
    f32x2 q = t * 0.5307027145f + (-0.7265760135f); q = q * t + 0.7107068705f; q = q * t + (-0.142248368f); q = q * t + 0.127414796f; q = q * t;
    const f32x2 s = (v * v) * (-0.72134752044f);
    f32x2 e; e.x = __builtin_amdgcn_exp2f(s.x); e.y = __builtin_amdgcn_exp2f(s.y);
    const f32x2 m = v * (q * e), r = v - m;
    f32x2 o; o.x = v.x < 0.f ? m.x : r.x; o.y = v.y < 0.f ? m.y : r.y; return o;
}

struct EpiF32 {
    static constexpr bool PERM = false, AFTER_DRAIN = false;
    float* C; int ldc; const float* bias;
    __device__ __forceinline__ void operator()(const f32x4 (&acc)[2][2][4][2], const Unit& u, int wr, int wc, int fr, int fq) const {
        const int row0 = u.pm * BM + wr * 64 + fr, col0 = u.pn * BM + wc * 32 + 4 * fq;
        f32x4 bv[2][2];
#pragma unroll
        for (int bj = 0; bj < 2; ++bj)
#pragma unroll
            for (int n = 0; n < 2; ++n) bv[bj][n] = bias ? *(const f32x4*)(bias + col0 + bj * HALF + n * 16) : (f32x4){0.f, 0.f, 0.f, 0.f};
#pragma unroll
        for (int ai = 0; ai < 2; ++ai)
#pragma unroll
            for (int m = 0; m < 4; ++m) { float* rowp = C + (size_t)(row0 + ai * HALF + m * 16) * ldc + col0;
#pragma unroll
                for (int bj = 0; bj < 2; ++bj)
#pragma unroll
                    for (int n = 0; n < 2; ++n) *(f32x4*)(rowp + bj * HALF + n * 16) = acc[ai][bj][m][n] + bv[bj][n]; }
    }
};
template <int ACT  > struct EpiBf16 {
    static constexpr bool PERM = true, AFTER_DRAIN = false; static_assert(ACT == 0 || ACT == 1, "EpiBf16: ACT is 0 (none) or 1 (gelu_pk)");
    bf16_t* O; int ldc; const float* bias; int split_cols; size_t split_stride; float scale0;
    __device__ __forceinline__ void operator()(const f32x4 (&acc)[2][2][4][2], const Unit& u, int wr, int wc, int fr, int fq) const {
        const int row0 = u.pm * BM + wr * 64 + fr; int colt = u.pn * BM; bf16_t* base = O;
        float sc = 1.f; if (split_cols) { const int t = colt / split_cols; base += (size_t)t * split_stride; colt -= t * split_cols; if (t == 0) sc = scale0; }
        const int col0 = colt + wc * 32 + 8 * fq, bcol0 = u.pn * BM + wc * 32 + 8 * fq;
        f32x4 bv[2][2];
#pragma unroll
        for (int bj = 0; bj < 2; ++bj)
#pragma unroll
            for (int n = 0; n < 2; ++n) bv[bj][n] = bias ? *(const f32x4*)(bias + bcol0 + bj * HALF + 4 * n) : (f32x4){0.f, 0.f, 0.f, 0.f};
#pragma unroll
        for (int ai = 0; ai < 2; ++ai)
#pragma unroll
            for (int m = 0; m < 4; ++m) { bf16_t* rowp = base + (size_t)(row0 + ai * HALF + m * 16) * ldc + col0;
#pragma unroll
                for (int bj = 0; bj < 2; ++bj) { f32x4 v0 = acc[ai][bj][m][0] + bv[bj][0], v1 = acc[ai][bj][m][1] + bv[bj][1];
                    if (ACT == 1) { f32x2 a = gelu_pk((f32x2){v0[0], v0[1]}), b = gelu_pk((f32x2){v0[2], v0[3]}), c = gelu_pk((f32x2){v1[0], v1[1]}), d = gelu_pk((f32x2){v1[2], v1[3]});
                        v0 = (f32x4){a.x, a.y, b.x, b.y}; v1 = (f32x4){c.x, c.y, d.x, d.y}; }
                    v0 = v0 * sc; v1 = v1 * sc; u32x4 w; w.x = cvt_pk_bf16(v0[0], v0[1]); w.y = cvt_pk_bf16(v0[2], v0[3]); w.z = cvt_pk_bf16(v1[0], v1[1]); w.w = cvt_pk_bf16(v1[2], v1[3]);
                    *(u32x4*)(rowp + bj * HALF) = w; } }
    }
};

struct PanelStats {
    unsigned* xbuf;
    unsigned* cnt;
    unsigned* tmo;
    int ntn; float eps;
    unsigned code;
    __device__ __forceinline__ bool run(const f32x4 (&v)[2][2][4][2], const Unit& u, int wr, int wc, int fr, int fq, PG8_LAS unsigned char* lds, int wid, int lane) const {
        typedef float f32x2v __attribute__((ext_vector_type(2)));
        PG8_LAS f32x2v* P = (PG8_LAS f32x2v*)lds;
        PG8_LAS f32x2v* S = (PG8_LAS f32x2v*)(lds + 8192);
        PG8_LAS unsigned* flag = (PG8_LAS unsigned*)(lds + 8192 + 2048);
#pragma unroll
        for (int ai = 0; ai < 2; ++ai)
#pragma unroll
            for (int m = 0; m < 4; ++m) {
                float s = 0.f;
#pragma unroll
                for (int bj = 0; bj < 2; ++bj)
#pragma unroll
                    for (int n = 0; n < 2; ++n) { const f32x4 x = v[ai][bj][m][n]; s += (x[0] + x[1]) + (x[2] + x[3]); }
                s += __shfl_xor(s, 16); s += __shfl_xor(s, 32);
                const float mw = s * (1.0f / 64.0f); float q = 0.f;
#pragma unroll
                for (int bj = 0; bj < 2; ++bj)
#pragma unroll
                    for (int n = 0; n < 2; ++n) { const f32x4 d = v[ai][bj][m][n] - mw; q += (d[0] * d[0] + d[1] * d[1]) + (d[2] * d[2] + d[3] * d[3]); }
                q += __shfl_xor(q, 16); q += __shfl_xor(q, 32);
                if (fq == 0) P[(ai * HALF + wr * 64 + m * 16 + fr) * 4 + wc] = (f32x2v){mw, q};
            }
        asm volatile("s_waitcnt lgkmcnt(0)" ::: "memory"); __builtin_amdgcn_s_barrier(); asm volatile("" ::: "memory");
#if defined(BROKEN_EXCHANGE_NO_WAIT)
#warning BROKEN CONTROL BUILD: the row-statistics exchange does not wait; results are wrong by design
        if (blockIdx.x >= 64) { const long long t0_ = clock64(); while (clock64() - t0_ < 60000) __builtin_amdgcn_s_sleep(8); }
#endif
        const int row = wid * 32 + (lane & 31);
        if (lane < 32) {
            const f32x2v a = P[row * 4 + 0], b = P[row * 4 + 1], c = P[row * 4 + 2], d = P[row * 4 + 3];
            const float mt = (a.x + b.x + c.x + d.x) * 0.25f;
            const float da = a.x - mt, db = b.x - mt, dc = c.x - mt, dd = d.x - mt;
            const float m2 = (a.y + b.y) + (c.y + d.y) + 64.0f * ((da * da + db * db) + (dc * dc + dd * dd));
            unsigned long long* slot = (unsigned long long*)xbuf + ((size_t)(u.pm * BM + row) * 4 + u.pn);
            __hip_atomic_store(slot, ((unsigned long long)__float_as_uint(m2) << 32) | __float_as_uint(mt), __ATOMIC_RELAXED, __HIP_MEMORY_SCOPE_AGENT);
        }
        asm volatile("s_waitcnt vmcnt(0)" ::: "memory");
        if (lane == 0) __hip_atomic_fetch_add(cnt + 64 * u.pm, 1u, __ATOMIC_RELAXED, __HIP_MEMORY_SCOPE_AGENT);
        if (wid == 0) {
            bool dead = false; const unsigned long long t0 = __builtin_amdgcn_s_memrealtime(); const unsigned want = 8u * (unsigned)ntn;
            for (;;) {
#if defined(BROKEN_EXCHANGE_NO_WAIT)
                break;
#endif
                if ((unsigned)__builtin_amdgcn_readfirstlane(__hip_atomic_load(cnt + 64 * u.pm, __ATOMIC_RELAXED, __HIP_MEMORY_SCOPE_AGENT)) >= want) break;
                if (__builtin_amdgcn_s_memrealtime() - t0 > 2000000ull) {
                    if (lane == 0) { unsigned expect = 0u; __hip_atomic_compare_exchange_strong(tmo + 1, &expect, code | (unsigned)(u.pm & 0xff), __ATOMIC_RELAXED, __ATOMIC_RELAXED, __HIP_MEMORY_SCOPE_AGENT);
                                     __hip_atomic_store(tmo, 1u, __ATOMIC_RELAXED, __HIP_MEMORY_SCOPE_AGENT); }
                    dead = true; break; }
                __builtin_amdgcn_s_sleep(2);
            }
            __builtin_amdgcn_fence(__ATOMIC_ACQUIRE, "agent");
            if (lane == 0) flag[0] = dead ? 1u : 0u;
        }
        asm volatile("s_waitcnt vmcnt(0) lgkmcnt(0)" ::: "memory"); __builtin_amdgcn_s_barrier(); asm volatile("" ::: "memory");
        const bool bad = flag[0] != 0u;
        if (lane < 32) {
            const unsigned long long* slot = (const unsigned long long*)xbuf + (size_t)(u.pm * BM + row) * 4; float mt[4], m2[4]; float ms = 0.f;
#pragma unroll
            for (int t = 0; t < 4; ++t) { if (t < ntn) { const unsigned long long w = __hip_atomic_load(slot + t, __ATOMIC_RELAXED, __HIP_MEMORY_SCOPE_AGENT); mt[t] = __uint_as_float((unsigned)w); m2[t] = __uint_as_float((unsigned)(w >> 32)); } else { mt[t] = 0.f; m2[t] = 0.f; } ms += mt[t]; }
            const float mean = ms / (float)ntn; float q = 0.f;
#pragma unroll
            for (int t = 0; t < 4; ++t) if (t < ntn) { const float dm = mt[t] - mean; q += m2[t] + 256.0f * dm * dm; }
            S[row] = (f32x2v){mean, 1.0f / sqrtf(q / (256.0f * (float)ntn) + eps)};
        }
        asm volatile("s_waitcnt lgkmcnt(0)" ::: "memory"); __builtin_amdgcn_s_barrier(); asm volatile("" ::: "memory");
        return bad;
    }
};
struct EpiLnRes {
    static constexpr bool PERM = false, AFTER_DRAIN = true;
    const float* base; float* out; int ldc; const float* bias; PanelStats st; unsigned poison;
    __device__ __forceinline__ void fused(f32x4 (&acc)[2][2][4][2], const Unit& u, int wr, int wc, int fr, int fq, PG8_LAS unsigned char* lds, int wid, int lane) const {
        typedef float f32x2v __attribute__((ext_vector_type(2)));
        const PG8_LAS f32x2v* S = (const PG8_LAS f32x2v*)(lds + 8192);
        const int col0 = u.pn * BM + wc * 32 + 4 * fq;
#pragma unroll
        for (int bj = 0; bj < 2; ++bj)
#pragma unroll
            for (int n = 0; n < 2; ++n) { const f32x4 bv = bias ? *(const f32x4*)(bias + col0 + bj * HALF + n * 16) : (f32x4){0.f, 0.f, 0.f, 0.f};
#pragma unroll
                for (int ai = 0; ai < 2; ++ai)
#pragma unroll
                    for (int m = 0; m < 4; ++m) acc[ai][bj][m][n] += bv; }
        f32x4 pre[4][2][2];
#pragma unroll
        for (int m = 0; m < 4; ++m) { const size_t off = (size_t)(u.pm * BM + wr * 64 + m * 16 + fr) * ldc + col0;
#pragma unroll
            for (int bj = 0; bj < 2; ++bj)
#pragma unroll
                for (int n = 0; n < 2; ++n) pre[m][bj][n] = *(const f32x4*)(base + off + bj * HALF + n * 16); }
        const bool bad = st.run(acc, u, wr, wc, fr, fq, lds, wid, lane) || poison != 0u;
        const float qnan = __builtin_nanf("");
#pragma unroll
        for (int ai = 0; ai < 2; ++ai)
#pragma unroll
            for (int m = 0; m < 4; ++m) { const int r = ai * HALF + wr * 64 + m * 16 + fr; const f32x2v sr = S[r]; const size_t off = (size_t)(u.pm * BM + r) * ldc + col0;
#pragma unroll
                for (int bj = 0; bj < 2; ++bj)
#pragma unroll
                    for (int n = 0; n < 2; ++n) { const f32x4 bs = ai == 0 ? pre[m][bj][n] : *(const f32x4*)(base + off + bj * HALF + n * 16); f32x4 o = bs + (acc[ai][bj][m][n] - sr.x) * sr.y;
                        if (bad) o = (f32x4){qnan, qnan, qnan, qnan}; *(f32x4*)(out + off + bj * HALF + n * 16) = o; }
                if (m & 1) asm volatile("" ::: "memory"); }
    }
};
struct EpiLnResLn {
    static constexpr bool PERM = false, AFTER_DRAIN = true;
    const float* base; float* out; bf16_t* xn; int ldc; const float* bias; PanelStats st1, st2; unsigned poison;
    __device__ __forceinline__ void fused(f32x4 (&acc)[2][2][4][2], const Unit& u, int wr, int wc, int fr, int fq, PG8_LAS unsigned char* lds, int wid, int lane) const {
        typedef float f32x2v __attribute__((ext_vector_type(2))); typedef unsigned u32x2v __attribute__((ext_vector_type(2)));
        const PG8_LAS f32x2v* S = (const PG8_LAS f32x2v*)(lds + 8192);
        const int col0 = u.pn * BM + wc * 32 + 4 * fq;
#pragma unroll
        for (int bj = 0; bj < 2; ++bj)
#pragma unroll
            for (int n = 0; n < 2; ++n) { const f32x4 bv = bias ? *(const f32x4*)(bias + col0 + bj * HALF + n * 16) : (f32x4){0.f, 0.f, 0.f, 0.f};
#pragma unroll
                for (int ai = 0; ai < 2; ++ai)
#pragma unroll
                    for (int m = 0; m < 4; ++m) acc[ai][bj][m][n] += bv; }
        bool bad = st1.run(acc, u, wr, wc, fr, fq, lds, wid, lane) || poison != 0u;
        const float qnan = __builtin_nanf("");
#pragma unroll
        for (int ai = 0; ai < 2; ++ai)
#pragma unroll
            for (int m = 0; m < 4; ++m) { const int r = ai * HALF + wr * 64 + m * 16 + fr; const f32x2v sr = S[r]; const size_t off = (size_t)(u.pm * BM + r) * ldc + col0;
#pragma unroll
                for (int bj = 0; bj < 2; ++bj)
#pragma unroll
                    for (int n = 0; n < 2; ++n) { const f32x4 bs = *(const f32x4*)(base + off + bj * HALF + n * 16); acc[ai][bj][m][n] = bs + (acc[ai][bj][m][n] - sr.x) * sr.y; }
                asm volatile("" : "+v"(acc[ai][0][m][0]), "+v"(acc[ai][0][m][1]), "+v"(acc[ai][1][m][0]), "+v"(acc[ai][1][m][1]));
                if (m & 1) asm volatile("" ::: "memory"); }
        const bool bad1 = bad;
        bad = st2.run(acc, u, wr, wc, fr, fq, lds, wid, lane) || bad;
#pragma unroll
        for (int ai = 0; ai < 2; ++ai)
#pragma unroll
            for (int m = 0; m < 4; ++m) { const int r = ai * HALF + wr * 64 + m * 16 + fr; const f32x2v sr = S[r]; const size_t off = (size_t)(u.pm * BM + r) * ldc + col0;
#pragma unroll
                for (int bj = 0; bj < 2; ++bj)
#pragma unroll
                    for (int n = 0; n < 2; ++n) { const f32x4 x1 = acc[ai][bj][m][n]; *(f32x4*)(out + off + bj * HALF + n * 16) = bad1 ? (f32x4){qnan, qnan, qnan, qnan} : x1;
                        const f32x4 o = (x1 - sr.x) * sr.y; u32x2v w; w.x = cvt_pk_bf16(o[0], o[1]); w.y = cvt_pk_bf16(o[2], o[3]);
                        if (bad) { w.x = 0x7fc07fc0u; w.y = 0x7fc07fc0u; } *(u32x2v*)(xn + off + bj * HALF + n * 16) = w; }
                asm volatile("" ::: "memory"); }
    }
};

template <class Epi, class Sched, bool ALIGN_EPI = false, bool SP2 = false>
__device__ __forceinline__ void gemm_phase(PG8_LAS unsigned char* lds, const Gemm g, const Sched& S, const Epi& E) {
    const int tid = threadIdx.x, wid = __builtin_amdgcn_readfirstlane(tid >> 6), lane = tid & 63, wr = wid >> 2, wc = wid & 3, fr = lane & 15, fq = lane >> 4;
    const int K = g.K, nt = K / BK;
    unsigned voffA[2], voffB[2];
#pragma unroll
    for (int i = 0; i < 2; ++i) { int R, C; stage_rc(tid * 16 + i * 8192, R, C); const int Rb = Epi::PERM ? ((R & ~31) + perm32(R & 31)) : R;
        voffA[i] = (unsigned)(R * K + C) * 2u; voffB[i] = (unsigned)(Rb * K + C) * 2u; }
    const size_t kstep = (size_t)(BK * 2);
    const size_t hstep = (size_t)HALF * K * 2;
    const size_t tstep = 2 * hstep;
    const unsigned ldsw = (unsigned)wid * 1024u;
    const int aoff = lds_byte(wr * 64 + fr, fq * 8), boff = lds_byte(wc * 32 + fr, fq * 8);
#define PG8_SA(b, h) (((b) * 2 + (h)) * HTB)
#define PG8_SB(b, h) ((4 + (b) * 2 + (h)) * HTB)
#define PG8_STAGE(bufoff, gbase, voff) do { _Pragma("unroll") for (int _i = 0; _i < 2; ++_i) \
        __builtin_amdgcn_global_load_lds((const unsigned*)((const char*)(gbase) + (voff)[_i]), (PG8_LAS unsigned*)(lds + (bufoff) + ldsw + _i * 8192), 16, 0, 0); } while (0)
#define PG8_LDA(dst, b, h) do { _Pragma("unroll") for (int m = 0; m < 4; ++m) _Pragma("unroll") for (int k = 0; k < 2; ++k) dst[m][k] = *(const PG8_LAS bf16x8*)(lds + PG8_SA(b, h) + aoff + m * 2048 + k * 1024); } while (0)
#define PG8_LDB(dst, b, h) do { _Pragma("unroll") for (int n = 0; n < 2; ++n) _Pragma("unroll") for (int k = 0; k < 2; ++k) dst[n][k] = *(const PG8_LAS bf16x8*)(lds + PG8_SB(b, h) + boff + n * 2048 + k * 1024); } while (0)
#define PG8_MMA(ai, bj, At, Bt) do { __builtin_amdgcn_s_setprio(1); _Pragma("unroll") for (int m = 0; m < 4; ++m) _Pragma("unroll") for (int n = 0; n < 2; ++n) _Pragma("unroll") for (int k = 0; k < 2; ++k) \
        acc[ai][bj][m][n] = __builtin_amdgcn_mfma_f32_16x16x32_bf16(Bt[n][k], At[m][k], acc[ai][bj][m][n], 0, 0, 0); __builtin_amdgcn_s_setprio(0); } while (0)
#define PG8_WAIT_V(n) asm volatile("s_waitcnt vmcnt(" #n ")" ::: "memory")
#define PG8_WAIT_L(n) asm volatile("s_waitcnt lgkmcnt(" #n ")" ::: "memory")
#define PG8_BAR __builtin_amdgcn_s_barrier()
#define PG8_SCHED __builtin_amdgcn_sched_barrier(0)
    Unit cur, nxt; int ui = 0;
    if (!S.next(0, cur)) return;
    f32x4 acc[2][2][4][2];
#pragma unroll
    for (int a = 0; a < 2; ++a)
#pragma unroll
        for (int b = 0; b < 2; ++b)
#pragma unroll
            for (int m = 0; m < 4; ++m)
#pragma unroll
                for (int n = 0; n < 2; ++n) acc[a][b][m][n] = (f32x4){0.f, 0.f, 0.f, 0.f};
    bf16x8 At[4][2], B0[2][2], B1[2][2];
    const char* cA = (const char*)g.A + (size_t)cur.pm * tstep; const char* cB = (const char*)g.Bt + (size_t)cur.pn * tstep;
    S.a_ready(cur);
    if constexpr (SP2) {
        PG8_STAGE(PG8_SB(0, 0), cB, voffB); PG8_STAGE(PG8_SB(0, 1), cB + hstep, voffB); PG8_STAGE(PG8_SA(0, 0), cA, voffA); PG8_STAGE(PG8_SA(0, 1), cA + hstep, voffA);
        if (wr == 1) PG8_BAR;
        PG8_WAIT_V(2); PG8_BAR;
        PG8_STAGE(PG8_SB(1, 0), cB + kstep, voffB); PG8_STAGE(PG8_SA(1, 0), cA + kstep, voffA); PG8_STAGE(PG8_SB(1, 1), cB + hstep + kstep, voffB);
        PG8_WAIT_V(6); PG8_BAR;
    } else {
        PG8_STAGE(PG8_SB(0, 0), cB, voffB); PG8_STAGE(PG8_SA(0, 0), cA, voffA); PG8_STAGE(PG8_SB(0, 1), cB + hstep, voffB); PG8_STAGE(PG8_SA(0, 1), cA + hstep, voffA);
        if (wr == 1) PG8_BAR;
        PG8_WAIT_V(4); PG8_BAR;
        PG8_STAGE(PG8_SB(1, 0), cB + kstep, voffB); PG8_STAGE(PG8_SA(1, 0), cA + kstep, voffA); PG8_STAGE(PG8_SB(1, 1), cB + hstep + kstep, voffB);
        PG8_WAIT_V(6); PG8_BAR;
    }
    for (;;) {
        const bool has_next = S.next(ui + 1, nxt);
        const char* nA = has_next ? (const char*)g.A + (size_t)nxt.pm * tstep : cA; const char* nB = has_next ? (const char*)g.Bt + (size_t)nxt.pn * tstep : cB;
        for (int t = 0; t < nt; t += 2) {
            const bool last = (t == nt - 2);
            const char* a1 = cA + (size_t)(t + 1) * kstep;
            const char* a2 = last ? nA : cA + (size_t)(t + 2) * kstep; const char* b2 = last ? nB : cB + (size_t)(t + 2) * kstep;
            const char* a3 = a2 + kstep; const char* b3 = b2 + kstep;
            if (last && has_next) S.a_ready(nxt);
            if constexpr (SP2) {
            PG8_LDB(B0, 0, 0); PG8_LDB(B1, 0, 1); PG8_SCHED; PG8_LDA(At, 0, 0); PG8_STAGE(PG8_SA(1, 1), a1 + hstep, voffA);
            PG8_WAIT_V(8); PG8_WAIT_L(0); PG8_BAR; PG8_MMA(0, 0, At, B0); PG8_MMA(0, 1, At, B1); PG8_BAR; PG8_SCHED;
            PG8_LDA(At, 0, 1); PG8_STAGE(PG8_SB(0, 0), b2, voffB); PG8_STAGE(PG8_SB(0, 1), b2 + hstep, voffB); PG8_STAGE(PG8_SA(0, 0), a2, voffA);
            PG8_WAIT_V(8); PG8_WAIT_L(0); PG8_BAR; PG8_MMA(1, 0, At, B0); PG8_MMA(1, 1, At, B1); PG8_BAR; PG8_SCHED;
            PG8_LDB(B0, 1, 0); PG8_LDB(B1, 1, 1); PG8_SCHED; PG8_LDA(At, 1, 0); PG8_STAGE(PG8_SA(0, 1), a2 + hstep, voffA);
            PG8_WAIT_V(8); PG8_WAIT_L(0); PG8_BAR; PG8_MMA(0, 0, At, B0); PG8_MMA(0, 1, At, B1); PG8_BAR; PG8_SCHED;
            PG8_LDA(At, 1, 1); PG8_STAGE(PG8_SB(1, 0), b3, voffB); PG8_STAGE(PG8_SB(1, 1), b3 + hstep, voffB); PG8_STAGE(PG8_SA(1, 0), a3, voffA);
            PG8_WAIT_V(8); PG8_WAIT_L(0); PG8_BAR; PG8_MMA(1, 0, At, B0); PG8_MMA(1, 1, At, B1); PG8_BAR; PG8_SCHED;
            } else {
            PG8_LDB(B0, 0, 0); PG8_SCHED; PG8_LDA(At, 0, 0); PG8_STAGE(PG8_SA(1, 1), a1 + hstep, voffA);
            PG8_WAIT_L(8); PG8_BAR; PG8_WAIT_L(0); PG8_MMA(0, 0, At, B0); PG8_BAR; PG8_SCHED;
            PG8_LDB(B1, 0, 1); PG8_STAGE(PG8_SB(0, 0), b2, voffB);
            PG8_BAR; PG8_WAIT_L(0); PG8_MMA(0, 1, At, B1); PG8_BAR;
            PG8_LDA(At, 0, 1); PG8_STAGE(PG8_SA(0, 0), a2, voffA);
            PG8_BAR; PG8_WAIT_L(0); PG8_MMA(1, 0, At, B0); PG8_BAR; PG8_SCHED;
            PG8_STAGE(PG8_SB(0, 1), b2 + hstep, voffB);
            PG8_WAIT_V(6); PG8_BAR; PG8_MMA(1, 1, At, B1); PG8_BAR;
            PG8_LDB(B0, 1, 0); PG8_SCHED; PG8_LDA(At, 1, 0); PG8_STAGE(PG8_SA(0, 1), a2 + hstep, voffA);
            PG8_WAIT_L(8); PG8_BAR; PG8_WAIT_L(0); PG8_MMA(0, 0, At, B0); PG8_BAR; PG8_SCHED;
            PG8_LDB(B1, 1, 1); PG8_STAGE(PG8_SB(1, 0), b3, voffB);
            PG8_BAR; PG8_WAIT_L(0); PG8_MMA(0, 1, At, B1); PG8_BAR;
            PG8_LDA(At, 1, 1); PG8_STAGE(PG8_SA(1, 0), a3, voffA);
            PG8_BAR; PG8_WAIT_L(0); PG8_MMA(1, 0, At, B0); PG8_BAR; PG8_SCHED;
            PG8_STAGE(PG8_SB(1, 1), b3 + hstep, voffB);
            PG8_WAIT_V(6); PG8_BAR; PG8_MMA(1, 1, At, B1); PG8_BAR;
            }
        }
        if constexpr (ALIGN_EPI) { if (wr == 0) PG8_BAR; }
        if constexpr (!Epi::AFTER_DRAIN) { E(acc, cur, wr, wc, fr, fq); S.done(cur); }
        if (!has_next) break;
#pragma unroll
        for (int a = 0; a < 2; ++a)
#pragma unroll
            for (int b = 0; b < 2; ++b)
#pragma unroll
                for (int m = 0; m < 4; ++m)
#pragma unroll
                    for (int n = 0; n < 2; ++n) acc[a][b][m][n] = (f32x4){0.f, 0.f, 0.f, 0.f};
        cur = nxt; cA = nA; cB = nB; ++ui;
        if constexpr (ALIGN_EPI) { if (wr == 1) PG8_BAR; }
    }
    PG8_WAIT_V(0);
    if constexpr (!ALIGN_EPI) { if (wr == 0) PG8_BAR; }
    PG8_BAR;
    if constexpr (Epi::AFTER_DRAIN) { E.fused(acc, cur, wr, wc, fr, fq, lds, wid, lane); S.done(cur); }
#undef PG8_SA
#undef PG8_SB
#undef PG8_STAGE
#undef PG8_LDA
#undef PG8_LDB
#undef PG8_MMA
#undef PG8_WAIT_V
#undef PG8_WAIT_L
#undef PG8_BAR
#undef PG8_SCHED
}
}

typedef unsigned short bf16;
constexpr int DM = 1024, SEQ = 8192, NB = 2, DEPTH = 4, SB = 128, SL = 8;
constexpr int NP = NB * SEQ;
constexpr int NS = SB * SL;
constexpr int NTOK = NP + NS;
constexpr int IN_DIM = 3332, PP = 3584;
constexpr int AU = 0, AV = 256, AZ = 512, BV = 768, BG = 1024, BZ = 1280, CQ = 1536, CK = 1792, CV = 1920, CZ = 2048, DZ = 2304, DX = 2560, DT = 3328;
constexpr float EPS = 1e-6f;
constexpr size_t O_YP = 0, O_YS = O_YP + (size_t)NP * DM, O_KP = O_YS + (size_t)NS * DM, O_KS = O_KP + 4 * 2 * 128 * 128, O_VP = O_KS + 4 * 128 * 8 * 128,
                 O_VS = O_VP + 4 * 2 * 128 * 128, O_CBP = O_VS + 4 * 128 * 8 * 128, O_CBS = O_CBP + 4 * 2 * 30 * 256, O_CDP = O_CBS + 4 * 128 * 8 * 256,
                 O_CDS = O_CDP + 4 * 2 * 3 * 768, O_SSP = O_CDS + (size_t)4 * 128 * 8 * 768, O_SSS = O_SSP + 4 * 2 * 4 * 64 * 128, O_AV = O_SSS + (size_t)4 * 128 * 4 * 64 * 128,
                 O_END = O_AV + 4 * 128 * 8 * 256;
constexpr size_t MiB = 1u << 20;
constexpr size_t WS_CTL = 0, WS_WIN = 2 * MiB, WS_WOUT = 30 * MiB, WS_PW = 38 * MiB, WS_HB = 40 * MiB, WS_MIX = 74 * MiB, WS_PROJ = 108 * MiB, WS_MIXED = WS_PROJ,
                 WS_YD = 227 * MiB, WS_ST = 243 * MiB, WS_AC = 259 * MiB, WS_CD = WS_AC + 512 * 1024, WS_END = 260 * MiB;
static_assert(WS_WIN + (size_t)DEPTH * PP * DM * 2 <= WS_WOUT && WS_HB + (size_t)NTOK * DM * 2 <= WS_MIX && WS_MIX + (size_t)NTOK * DM * 2 <= WS_PROJ &&
              WS_PROJ + (size_t)NTOK * PP * 2 <= WS_YD && WS_MIXED + (size_t)NTOK * DM * 4 <= WS_YD, "ws map");

struct P {
    const float *x_prompt, *x_sample, *cache_k, *cache_v, *st_conv_b, *st_conv_d, *st_ssm, *norm_pre, *norm_post, *w_in, *w_out, *a_ln_g, *a_ln_b, *a_ws, *a_wb,
        *b_conv_w, *b_conv_b, *b_ln_g, *b_ln_b, *b_pw_w, *b_pw_b, *c_sinks, *d_conv_w, *d_conv_b, *d_dt_bias, *d_a_log, *d_skip, *d_norm_g;
    float* out;
    bf16 *win_t, *wout_t, *hb, *mix, *proj;
    float *mixed, *yd, *states, *acum, *cdec;
    int layer, pad;
};

__device__ __forceinline__ float bf2f(bf16 v) { return __uint_as_float((unsigned)v << 16); }
__device__ __forceinline__ bf16 f2bf(float f) { unsigned u = __float_as_uint(f); return (bf16)((u + 0x7fffu + ((u >> 16) & 1u)) >> 16); }
__device__ __forceinline__ float sigmoid_(float x) { return 1.f / (1.f + __expf(-x)); }
__device__ __forceinline__ float silu_(float x) { return x / (1.f + __expf(-x)); }
__device__ __forceinline__ float gelu_(float x) { const float u = 0.7978845608028654f * (x + 0.044715f * x * x * x); return x / (1.f + __expf(-2.f * u)); }
__device__ __forceinline__ float softplus_(float x) { return x > 20.f ? x : log1pf(__expf(x)); }
__device__ __forceinline__ float wave_sum(float v) {
#pragma unroll
    for (int o = 1; o < 64; o <<= 1) v += __shfl_xor(v, o);
    return v;
}

__global__ void __launch_bounds__(256) k_transpose(const float* W, int K, int N, bf16* WT, int Npad) {
    __shared__ float tile[32][33];
    W += (size_t)blockIdx.z * K * N; WT += (size_t)blockIdx.z * Npad * K;
    const int n0 = blockIdx.x * 32, k0 = blockIdx.y * 32, tx = threadIdx.x & 31, ty = threadIdx.x >> 5;
    for (int i = ty; i < 32; i += 8) { const int n = n0 + tx; tile[i][tx] = (n < N) ? W[(size_t)(k0 + i) * N + n] : 0.f; }
    __syncthreads();
    for (int i = ty; i < 32; i += 8) WT[(size_t)(n0 + i) * K + k0 + tx] = f2bf(tile[tx][i]);
}

__global__ void __launch_bounds__(512) k_norm0(P p) {
    const int lane = threadIdx.x & 63, gw = blockIdx.x * 8 + (threadIdx.x >> 6), ngw = gridDim.x * 8;
    for (int r = gw; r < NTOK; r += ngw) {
        const float* src = r < NP ? p.x_prompt + (size_t)r * DM : p.x_sample + (size_t)(r - NP) * DM;
        float4 v[4]; float ss = 0.f;
#pragma unroll
        for (int j = 0; j < 4; ++j) { v[j] = ((const float4*)src)[lane + 64 * j]; ss += v[j].x * v[j].x + v[j].y * v[j].y + v[j].z * v[j].z + v[j].w * v[j].w; }
        const float rstd = rsqrtf(wave_sum(ss) * (1.f / DM) + EPS);
#pragma unroll
        for (int j = 0; j < 4; ++j) {
            ((float4*)(p.out + (size_t)r * DM))[lane + 64 * j] = v[j];
            const float4 g = ((const float4*)p.norm_pre)[lane + 64 * j];
            ushort4 o; o.x = f2bf(v[j].x * rstd * g.x); o.y = f2bf(v[j].y * rstd * g.y); o.z = f2bf(v[j].z * rstd * g.z); o.w = f2bf(v[j].w * rstd * g.w);
            ((ushort4*)(p.hb + (size_t)r * DM))[lane + 64 * j] = o;
        }
    }
}
__global__ void __launch_bounds__(512) k_post(P p) {
    const int l = p.layer, lane = threadIdx.x & 63, gw = blockIdx.x * 8 + (threadIdx.x >> 6), ngw = gridDim.x * 8;
    for (int r = gw; r < NTOK; r += ngw) {
        float4 m[4], x[4]; float ss = 0.f;
#pragma unroll
        for (int j = 0; j < 4; ++j) { m[j] = ((const float4*)(p.mixed + (size_t)r * DM))[lane + 64 * j]; ss += m[j].x * m[j].x + m[j].y * m[j].y + m[j].z * m[j].z + m[j].w * m[j].w; }
        const float rstd = rsqrtf(wave_sum(ss) * (1.f / DM) + EPS);
        float sx = 0.f;
#pragma unroll
        for (int j = 0; j < 4; ++j) {
            x[j] = ((const float4*)(p.out + (size_t)r * DM))[lane + 64 * j];
            const float4 g = ((const float4*)(p.norm_post + l * DM))[lane + 64 * j];
            x[j].x += m[j].x * rstd * g.x; x[j].y += m[j].y * rstd * g.y; x[j].z += m[j].z * rstd * g.z; x[j].w += m[j].w * rstd * g.w;
            sx += x[j].x * x[j].x + x[j].y * x[j].y + x[j].z * x[j].z + x[j].w * x[j].w;
            ((float4*)(p.out + (size_t)r * DM))[lane + 64 * j] = x[j];
        }
        if (l + 1 < DEPTH) {
            const float rx = rsqrtf(wave_sum(sx) * (1.f / DM) + EPS);
#pragma unroll
            for (int j = 0; j < 4; ++j) {
                const float4 g = ((const float4*)(p.norm_pre + (l + 1) * DM))[lane + 64 * j];
                ushort4 o; o.x = f2bf(x[j].x * rx * g.x); o.y = f2bf(x[j].y * rx * g.y); o.z = f2bf(x[j].z * rx * g.z); o.w = f2bf(x[j].w * rx * g.w);
                ((ushort4*)(p.hb + (size_t)r * DM))[lane + 64 * j] = o;
            }
        }
    }
}

template <class Epi> __global__ void __launch_bounds__(512, 2) k_gemm(pg8::Gemm g, Epi E) {
    extern __shared__ __attribute__((aligned(16))) unsigned char lds[];
    pg8::StaticOrder S; S.init(g.M, g.N, (int)gridDim.x, (int)blockIdx.x);
    pg8::gemm_phase<Epi, pg8::StaticOrder, true, true>((PG8_LAS unsigned char*)lds, g, S, E);
}

__device__ void mixA_item(const P& p, int item, float* lds) {
    const int l = p.layer, tid = threadIdx.x, lane = tid & 63, wave = tid >> 6;
    const bool sample = item >= 128;
    const int q = sample ? 8 : 128, row0 = sample ? NP + (item - 128) * 8 : item * 128;
    const float* lng = p.a_ln_g + l * 256; const float* lnb = p.a_ln_b + l * 256;
    for (int t = wave; t < q; t += 8) {
        const bf16* pr = p.proj + (size_t)(row0 + t) * PP + AV + lane * 4;
        const ushort4 raw = *(const ushort4*)pr;
        float g[4] = {gelu_(bf2f(raw.x)), gelu_(bf2f(raw.y)), gelu_(bf2f(raw.z)), gelu_(bf2f(raw.w))};
        const float mean = wave_sum(g[0] + g[1] + g[2] + g[3]) * (1.f / 256.f);
        float d2 = 0.f;
#pragma unroll
        for (int k = 0; k < 4; ++k) { g[k] -= mean; d2 += g[k] * g[k]; }
        const float rstd = rsqrtf(wave_sum(d2) * (1.f / 256.f) + EPS);
#pragma unroll
        for (int k = 0; k < 4; ++k) {
            const float v = g[k] * rstd * lng[lane * 4 + k] + lnb[lane * 4 + k];
            lds[t * 256 + lane * 4 + k] = v;
            if (sample) p.out[O_AV + ((size_t)(l * 128 + (item - 128)) * 8 + t) * 256 + lane * 4 + k] = v;
        }
    }
    __syncthreads();
    const int c = tid & 255, th = tid >> 8, h = c >> 6;
    const float* W = p.a_ws + (size_t)(l * 4 + h) * 128 * 128; const float* wb = p.a_wb + (l * 4 + h) * 128;
    for (int t = th; t < q; t += 2) {
        float acc = 0.f; const float* wr = W + t * 128;
        for (int s = 0; s <= t; ++s) acc += wr[s] * lds[s * 256 + c];
        acc += wb[t];
        const bf16* pr = p.proj + (size_t)(row0 + t) * PP;
        const float u = gelu_(bf2f(pr[AU + c])), z = bf2f(pr[AZ + c]);
        p.mix[(size_t)(row0 + t) * DM + c] = f2bf(u * acc * silu_(z));
    }
    __syncthreads();
}
__global__ void __launch_bounds__(512) k_mixA(P p) {
    extern __shared__ __attribute__((aligned(16))) unsigned char lds[];
    for (int it = blockIdx.x; it < 256; it += gridDim.x) mixA_item(p, it, (float*)lds);
}

__device__ void mixB_item(const P& p, int item, float* lds) {
    const int l = p.layer, tid = threadIdx.x, lane = tid & 63, wave = tid >> 6;
    float* glu = lds; float* cln = lds + 62 * 256;
    const bool sample = item >= 512;
    const int nt = sample ? 8 : 32, b = sample ? 0 : item >> 8, t0 = sample ? 0 : (item & 255) * 32, n = item - 512;
    const int row0 = sample ? NP + n * 8 : b * SEQ + t0;
    for (int j = wave; j < nt + 30; j += 8) {
        float g[4] = {0.f, 0.f, 0.f, 0.f};
        int srow = -1;
        if (!sample) { const int t = t0 - 30 + j; if (t >= 0) srow = b * SEQ + t; }
        else { if (j >= 30) srow = row0 + j - 30; else { const float4 s4 = *(const float4*)(p.st_conv_b + ((size_t)(l * 128 + n) * 30 + j) * 256 + lane * 4); g[0] = s4.x; g[1] = s4.y; g[2] = s4.z; g[3] = s4.w; } }
        if (srow >= 0) {
            const ushort4 v = *(const ushort4*)(p.proj + (size_t)srow * PP + BV + lane * 4);
            const ushort4 gg = *(const ushort4*)(p.proj + (size_t)srow * PP + BG + lane * 4);
            g[0] = bf2f(v.x) * sigmoid_(bf2f(gg.x)); g[1] = bf2f(v.y) * sigmoid_(bf2f(gg.y)); g[2] = bf2f(v.z) * sigmoid_(bf2f(gg.z)); g[3] = bf2f(v.w) * sigmoid_(bf2f(gg.w));
        }
#pragma unroll
        for (int k = 0; k < 4; ++k) glu[j * 256 + lane * 4 + k] = g[k];
        if (sample && j >= 30) *(float4*)(p.out + O_CBS + ((size_t)(l * 128 + n) * 8 + (j - 30)) * 256 + lane * 4) = make_float4(g[0], g[1], g[2], g[3]);
        if (!sample) { const int t = t0 - 30 + j; if (t >= SEQ - 30) *(float4*)(p.out + O_CBP + ((size_t)(l * 2 + b) * 30 + (t - (SEQ - 30))) * 256 + lane * 4) = make_float4(g[0], g[1], g[2], g[3]); }
    }
    __syncthreads();
    for (int t = wave; t < nt; t += 8) {
        float c[4];
#pragma unroll
        for (int k = 0; k < 4; ++k) c[k] = p.b_conv_b[l * 256 + lane * 4 + k];
#pragma unroll 1
        for (int j = 0; j < 31; ++j) {
            const float4 w = *(const float4*)(p.b_conv_w + (size_t)(l * 31 + j) * 256 + lane * 4);
            const float* gr = glu + (t + j) * 256 + lane * 4;
            c[0] += w.x * gr[0]; c[1] += w.y * gr[1]; c[2] += w.z * gr[2]; c[3] += w.w * gr[3];
        }
        const float mean = wave_sum(c[0] + c[1] + c[2] + c[3]) * (1.f / 256.f);
        float d2 = 0.f;
#pragma unroll
        for (int k = 0; k < 4; ++k) { c[k] -= mean; d2 += c[k] * c[k]; }
        const float rstd = rsqrtf(wave_sum(d2) * (1.f / 256.f) + EPS);
#pragma unroll
        for (int k = 0; k < 4; ++k) cln[t * 256 + lane * 4 + k] = silu_(c[k] * rstd * p.b_ln_g[l * 256 + lane * 4 + k] + p.b_ln_b[l * 256 + lane * 4 + k]);
    }
    __syncthreads();
    const int co = tid & 255, th = tid >> 8, half = nt >> 1, tb = th * half;
    float acc[16];
#pragma unroll
    for (int i = 0; i < 16; ++i) acc[i] = 0.f;
    const float* pw = p.b_pw_w + (size_t)l * 256 * 256 + co;
#pragma unroll 2
    for (int ci = 0; ci < 256; ++ci) {
        const float w = pw[(size_t)ci * 256];
#pragma unroll
        for (int i = 0; i < 16; ++i) if (i < half) acc[i] += cln[(tb + i) * 256 + ci] * w;
    }
    const float pb = p.b_pw_b[l * 256 + co];
#pragma unroll
    for (int i = 0; i < 16; ++i) if (i < half) {
        const size_t row = (size_t)(row0 + tb + i);
        const float z = bf2f(p.proj[row * PP + BZ + co]);
        p.mix[row * DM + 256 + co] = f2bf((acc[i] + pb) * silu_(z));
    }
    __syncthreads();
}
__global__ void __launch_bounds__(512) k_mixB(P p) {
    extern __shared__ __attribute__((aligned(16))) unsigned char lds[];
    for (int it = blockIdx.x; it < 640; it += gridDim.x) mixB_item(p, it, (float*)lds);
}

__device__ void mixC_item(const P& p, int item, float* lds) {
    const int l = p.layer, tid = threadIdx.x;
    float* Ks = lds; float* Vs = lds + 256 * 65;
    const bool sample = item >= 256;
    const int kh = item & 1, b = item >> 7, qb = (item >> 1) & 63, n = (item - 256) >> 1;
    if (!sample) {
        for (int idx = tid; idx < 256 * 64; idx += 512) {
            const int j = idx >> 6, d = idx & 63, pos = (qb - 1) * 128 + j;
            float kv = 0.f, vv = 0.f;
            if (pos >= 0) { const size_t row = (size_t)b * SEQ + pos; kv = bf2f(p.proj[row * PP + CK + kh * 64 + d]); vv = bf2f(p.proj[row * PP + CV + kh * 64 + d]); }
            Ks[j * 65 + d] = kv; Vs[j * 65 + d] = vv;
            if (qb == 63 && j >= 128) { const size_t o = (((size_t)(l * 2 + b) * 128 + (j - 128)) * 2 + kh) * 64 + d; p.out[O_KP + o] = kv; p.out[O_VP + o] = vv; }
        }
    } else {
        for (int idx = tid; idx < 136 * 64; idx += 512) {
            const int j = idx >> 6, d = idx & 63;
            float kv, vv;
            if (j < 128) { const size_t o = ((((size_t)l * 128 + n) * 128 + j) * 2 + kh) * 64 + d; kv = p.cache_k[o]; vv = p.cache_v[o]; }
            else { const size_t row = (size_t)NP + n * 8 + (j - 128); kv = bf2f(p.proj[row * PP + CK + kh * 64 + d]); vv = bf2f(p.proj[row * PP + CV + kh * 64 + d]);
                   const size_t o = (((size_t)(l * 128 + n) * 8 + (j - 128)) * 2 + kh) * 64 + d; p.out[O_KS + o] = kv; p.out[O_VS + o] = vv; }
            Ks[j * 65 + d] = kv; Vs[j * 65 + d] = vv;
        }
    }
    __syncthreads();
    const int nq = sample ? 8 : 128;
    if (tid < 2 * nq) {
        const int qi = tid % nq, g = tid / nq, h = kh * 2 + g;
        const size_t row = sample ? (size_t)NP + n * 8 + qi : (size_t)b * SEQ + qb * 128 + qi;
        float qv[64], o[64];
#pragma unroll
        for (int d = 0; d < 64; ++d) { qv[d] = bf2f(p.proj[row * PP + CQ + h * 64 + d]) * 0.125f; o[d] = 0.f; }
        const float slope = exp2f(-2.f * (float)(h + 1));
        float m = p.c_sinks[l * 4 + h], lsum = 1.f;
        for (int j = qi; j <= qi + 128; ++j) {
            if (!sample && (qb - 1) * 128 + j < 0) continue;
            float s = 0.f;
#pragma unroll
            for (int d = 0; d < 64; ++d) s += qv[d] * Ks[j * 65 + d];
            s -= slope * (float)(qi + 128 - j);
            const float mn = fmaxf(m, s), sc = __expf(m - mn), pe = __expf(s - mn);
            lsum = lsum * sc + pe;
#pragma unroll
            for (int d = 0; d < 64; ++d) o[d] = o[d] * sc + pe * Vs[j * 65 + d];
            m = mn;
        }
        const float inv = 1.f / lsum;
#pragma unroll
        for (int d = 0; d < 64; ++d) {
            const float z = bf2f(p.proj[row * PP + CZ + h * 64 + d]);
            p.mix[row * DM + 512 + h * 64 + d] = f2bf(o[d] * inv * silu_(z));
        }
    }
    __syncthreads();
}
__global__ void __launch_bounds__(512) k_mixC(P p) {
    extern __shared__ __attribute__((aligned(16))) unsigned char lds[];
    for (int it = blockIdx.x; it < 512; it += gridDim.x) mixC_item(p, it, (float*)lds);
}

__device__ void mixD_local_item(const P& p, int item, unsigned char* ldsb) {
    const int l = p.layer, tid = threadIdx.x;
    bf16* Xs = (bf16*)ldsb; bf16* Bs = Xs + 128 * 128; bf16* Cs = Bs + 128 * 128; bf16* Ss = Cs + 128 * 128;
    float* dts = (float*)(Ss + 128 * 128); float* acs = dts + 256; float* wts = acs + 256;
    const int cidx = item >> 1, g = item & 1, b = cidx >> 6, c = cidx & 63, t0 = c * 128; const size_t row0 = (size_t)b * SEQ + t0;
    for (int idx = tid; idx < 128 * 384; idx += 512) {
        const int t = idx / 384, cc = idx % 384, part = cc >> 7, col = cc & 127, xcol = part * 256 + g * 128 + col;
        float acc = p.d_conv_b[l * 768 + xcol];
#pragma unroll
        for (int j = 0; j < 4; ++j) { const int tt = t0 + t - 3 + j; if (tt >= 0) acc += p.d_conv_w[(l * 4 + j) * 768 + xcol] * bf2f(p.proj[((size_t)b * SEQ + tt) * PP + DX + xcol]); }
        const bf16 v = f2bf(silu_(acc));
        (part == 0 ? Xs : part == 1 ? Bs : Cs)[t * 128 + col] = v;
        if (c == 63 && t >= 125) p.out[O_CDP + ((size_t)(l * 2 + b) * 3 + (t - 125)) * 768 + xcol] = bf2f(p.proj[(row0 + t) * PP + DX + xcol]);
    }
    if (tid < 256) { const int h2 = tid >> 7, t = tid & 127, h = 2 * g + h2; dts[h2 * 128 + t] = softplus_(bf2f(p.proj[(row0 + t) * PP + DT + h]) + p.d_dt_bias[l * 4 + h]); }
    __syncthreads();
    if (tid < 2) { const int h = 2 * g + tid; const float a = -__expf(p.d_a_log[l * 4 + h]); float s = 0.f; for (int t = 0; t < 128; ++t) { s += dts[tid * 128 + t] * a; acs[tid * 128 + t] = s; } }
    __syncthreads();
    if (tid < 256) { const int h2 = tid >> 7, t = tid & 127, h = 2 * g + h2; p.acum[(row0 + t) * 4 + h] = acs[h2 * 128 + t]; }
    float gv[32];
    { const int t = tid >> 2;
#pragma unroll
      for (int i = 0; i < 32; ++i) { const int s = (tid & 3) + 4 * i; float acc = 0.f; if (s <= t) {
#pragma unroll 4
          for (int nn = 0; nn < 128; ++nn) acc += bf2f(Cs[t * 128 + nn]) * bf2f(Bs[s * 128 + nn]); } gv[i] = acc; } }
    for (int h2 = 0; h2 < 2; ++h2) {
        const int h = 2 * g + h2; const float aclast = acs[h2 * 128 + 127];
        { const int t = tid >> 2;
#pragma unroll
          for (int i = 0; i < 32; ++i) { const int s = (tid & 3) + 4 * i; Ss[t * 128 + s] = f2bf(s <= t ? gv[i] * __expf(acs[h2 * 128 + t] - acs[h2 * 128 + s]) * dts[h2 * 128 + s] : 0.f); } }
        if (tid < 128) wts[tid] = __expf(aclast - acs[h2 * 128 + tid]) * dts[h2 * 128 + tid];
        __syncthreads();
        { const int pcol = tid & 63, tq = tid >> 6; const float dsk = p.d_skip[l * 4 + h];
#pragma unroll 1
          for (int i = 0; i < 16; ++i) { const int t2 = tq + 8 * i; float acc = 0.f;
#pragma unroll 4
              for (int s = 0; s <= t2; ++s) acc += bf2f(Ss[t2 * 128 + s]) * bf2f(Xs[s * 128 + h2 * 64 + pcol]);
              acc += dsk * bf2f(Xs[t2 * 128 + h2 * 64 + pcol]);
              p.yd[(row0 + t2) * 256 + h * 64 + pcol] = acc; } }
        { const int nn = tid & 127, pq = tid >> 7;
#pragma unroll 1
          for (int i = 0; i < 16; ++i) { const int pp = pq + 4 * i; float acc = 0.f;
#pragma unroll 4
              for (int s = 0; s < 128; ++s) acc += wts[s] * bf2f(Xs[s * 128 + h2 * 64 + pp]) * bf2f(Bs[s * 128 + nn]);
              p.states[((size_t)(cidx * 4 + h) * 64 + pp) * 128 + nn] = acc; } }
        if (tid == 0) p.cdec[cidx * 4 + h] = __expf(aclast);
        __syncthreads();
    }
}
__global__ void __launch_bounds__(512) k_mixD_local(P p) {
    extern __shared__ __attribute__((aligned(16))) unsigned char lds[];
    for (int it = blockIdx.x; it < 256; it += gridDim.x) mixD_local_item(p, it, lds);
}
__global__ void __launch_bounds__(512) k_scan(P p) {
    const int l = p.layer;
    for (int e = blockIdx.x * 512 + threadIdx.x; e < NB * 4 * 64 * 128; e += gridDim.x * 512) {
        const int b = e >> 15, h = (e >> 13) & 3, pn = e & 8191;
        float hp = 0.f;
        for (int c = 0; c < 64; ++c) { const size_t o = ((size_t)((b * 64 + c) * 4 + h)) * 8192 + pn; const float st = p.states[o]; p.states[o] = hp; hp = hp * p.cdec[(b * 64 + c) * 4 + h] + st; }
        p.out[O_SSP + ((size_t)(l * 2 + b) * 4 + h) * 8192 + pn] = hp;
    }
}
__device__ void mixD_finish_item(const P& p, int item, unsigned char* ldsb) {
    const int l = p.layer, tid = threadIdx.x, lane = tid & 63, wave = tid >> 6;
    bf16* Cs = (bf16*)ldsb; float* Hin = (float*)(ldsb + 128 * 128 * 2);
    const int cidx = item >> 1, g = item & 1, b = cidx >> 6, c = cidx & 63, t0 = c * 128; const size_t row0 = (size_t)b * SEQ + t0;
    for (int idx = tid; idx < 128 * 128; idx += 512) {
        const int t = idx >> 7, col = idx & 127, xcol = 512 + g * 128 + col;
        float acc = p.d_conv_b[l * 768 + xcol];
#pragma unroll
        for (int j = 0; j < 4; ++j) { const int tt = t0 + t - 3 + j; if (tt >= 0) acc += p.d_conv_w[(l * 4 + j) * 768 + xcol] * bf2f(p.proj[((size_t)b * SEQ + tt) * PP + DX + xcol]); }
        Cs[t * 128 + col] = f2bf(silu_(acc));
    }
    for (int idx = tid; idx < 128 * 128; idx += 512) { const int hp = idx >> 7, nn = idx & 127; Hin[hp * 129 + nn] = p.states[((size_t)(cidx * 4 + 2 * g + (hp >> 6)) * 64 + (hp & 63)) * 128 + nn]; }
    __syncthreads();
    for (int t = wave; t < 128; t += 8) {
        float y[2]; float ss = 0.f;
#pragma unroll
        for (int k = 0; k < 2; ++k) {
            const int hp = lane + 64 * k, h = 2 * g + k;
            float acc = 0.f;
            for (int nn = 0; nn < 128; ++nn) acc += bf2f(Cs[t * 128 + nn]) * Hin[hp * 129 + nn];
            float v = p.yd[(row0 + t) * 256 + g * 128 + hp] + __expf(p.acum[(row0 + t) * 4 + h]) * acc;
            v *= silu_(bf2f(p.proj[(row0 + t) * PP + DZ + g * 128 + hp]));
            y[k] = v; ss += v * v;
        }
        const float rstd = rsqrtf(wave_sum(ss) * (1.f / 128.f) + EPS);
#pragma unroll
        for (int k = 0; k < 2; ++k) { const int hp = lane + 64 * k; p.mix[(row0 + t) * DM + 768 + g * 128 + hp] = f2bf(y[k] * rstd * p.d_norm_g[l * 256 + g * 128 + hp]); }
    }
    __syncthreads();
}
__global__ void __launch_bounds__(512) k_mixD_finish(P p) {
    extern __shared__ __attribute__((aligned(16))) unsigned char lds[];
    for (int it = blockIdx.x; it < 256; it += gridDim.x) mixD_finish_item(p, it, lds);
}
__device__ void mixD_sample_item(const P& p, int item, float* lds) {
    const int l = p.layer, tid = threadIdx.x, lane = tid & 63, wave = tid >> 6;
    float* X8 = lds; float* B8 = X8 + 8 * 128; float* C8 = B8 + 8 * 128; float* Y8 = C8 + 8 * 128; float* dt8 = Y8 + 8 * 128;
    const int n = item >> 1, g = item & 1; const size_t row0 = (size_t)NP + n * 8;
    for (int idx = tid; idx < 8 * 384; idx += 512) {
        const int t = idx / 384, cc = idx % 384, part = cc >> 7, col = cc & 127, xcol = part * 256 + g * 128 + col;
        float acc = p.d_conv_b[l * 768 + xcol];
#pragma unroll
        for (int j = 0; j < 4; ++j) { const int tt = t - 3 + j;
            const float xv = tt >= 0 ? bf2f(p.proj[(row0 + tt) * PP + DX + xcol]) : p.st_conv_d[((size_t)(l * 128 + n) * 3 + (tt + 3)) * 768 + xcol];
            acc += p.d_conv_w[(l * 4 + j) * 768 + xcol] * xv; }
        (part == 0 ? X8 : part == 1 ? B8 : C8)[t * 128 + col] = bf2f(f2bf(silu_(acc)));
        p.out[O_CDS + ((size_t)(l * 128 + n) * 8 + t) * 768 + xcol] = bf2f(p.proj[(row0 + t) * PP + DX + xcol]);
    }
    if (tid < 16) { const int h2 = tid >> 3, t = tid & 7, h = 2 * g + h2; dt8[h2 * 8 + t] = softplus_(bf2f(p.proj[(row0 + t) * PP + DT + h]) + p.d_dt_bias[l * 4 + h]); }
    __syncthreads();
    const int h2 = tid >> 8, pp = (tid >> 2) & 63, nr = (tid & 3) * 32, h = 2 * g + h2;
    const float a = -__expf(p.d_a_log[l * 4 + h]), dsk = p.d_skip[l * 4 + h];
    float hs[32];
    const size_t so = (((size_t)(l * 128 + n) * 4 + h) * 64 + pp) * 128 + nr;
#pragma unroll
    for (int k = 0; k < 32; k += 4) { const float4 v = *(const float4*)(p.st_ssm + so + k); hs[k] = v.x; hs[k + 1] = v.y; hs[k + 2] = v.z; hs[k + 3] = v.w; }
    for (int t = 0; t < 8; ++t) {
        const float dt = dt8[h2 * 8 + t], dA = __expf(dt * a), xv = X8[t * 128 + h2 * 64 + pp] * dt;
        float part = 0.f;
#pragma unroll
        for (int k = 0; k < 32; ++k) { hs[k] = hs[k] * dA + xv * B8[t * 128 + nr + k]; part += C8[t * 128 + nr + k] * hs[k]; }
        part += __shfl_xor(part, 1); part += __shfl_xor(part, 2);
        if ((tid & 3) == 0) Y8[t * 128 + h2 * 64 + pp] = part + dsk * X8[t * 128 + h2 * 64 + pp];
    }
#pragma unroll
    for (int k = 0; k < 32; k += 4) *(float4*)(p.out + O_SSS + so + k) = make_float4(hs[k], hs[k + 1], hs[k + 2], hs[k + 3]);
    __syncthreads();
    { const int t = wave; float y[2]; float ss = 0.f;
#pragma unroll
      for (int k = 0; k < 2; ++k) { const int hp = lane + 64 * k; float v = Y8[t * 128 + hp] * silu_(bf2f(p.proj[(row0 + t) * PP + DZ + g * 128 + hp])); y[k] = v; ss += v * v; }
      const float rstd = rsqrtf(wave_sum(ss) * (1.f / 128.f) + EPS);
#pragma unroll
      for (int k = 0; k < 2; ++k) { const int hp = lane + 64 * k; p.mix[(row0 + t) * DM + 768 + g * 128 + hp] = f2bf(y[k] * rstd * p.d_norm_g[l * 256 + g * 128 + hp]); } }
    __syncthreads();
}
__global__ void __launch_bounds__(512) k_mixD_sample(P p) {
    extern __shared__ __attribute__((aligned(16))) unsigned char lds[];
    for (int it = blockIdx.x; it < 256; it += gridDim.x) mixD_sample_item(p, it, (float*)lds);
}

constexpr int LDS_BYTES = 147456;
extern "C" void kernel_launch(void* const* d_in, const int* in_sizes, int n_in, void* d_out, int out_size, void* d_ws, size_t ws_size, hipStream_t stream) {
    static int ok = 0;
    if (ok == 0) {
        if (n_in != 28 || in_sizes[0] != NP * DM || (size_t)out_size != O_END || ws_size < WS_END) {
            fprintf(stderr, "kernel_launch: unexpected shapes: n_in %d in0 %d out %d (want %zu) ws %zu (want >= %zu)\n", n_in, n_in > 0 ? in_sizes[0] : -1, out_size, (size_t)O_END, ws_size, (size_t)WS_END);
            ok = -1; return; }
        (void)hipFuncSetAttribute((const void*)k_gemm<pg8::EpiBf16<0>>, hipFuncAttributeMaxDynamicSharedMemorySize, LDS_BYTES);
        (void)hipFuncSetAttribute((const void*)k_gemm<pg8::EpiF32>, hipFuncAttributeMaxDynamicSharedMemorySize, LDS_BYTES);
        (void)hipFuncSetAttribute((const void*)k_mixA, hipFuncAttributeMaxDynamicSharedMemorySize, LDS_BYTES);
        (void)hipFuncSetAttribute((const void*)k_mixB, hipFuncAttributeMaxDynamicSharedMemorySize, LDS_BYTES);
        (void)hipFuncSetAttribute((const void*)k_mixC, hipFuncAttributeMaxDynamicSharedMemorySize, LDS_BYTES);
        (void)hipFuncSetAttribute((const void*)k_mixD_local, hipFuncAttributeMaxDynamicSharedMemorySize, LDS_BYTES);
        (void)hipFuncSetAttribute((const void*)k_mixD_finish, hipFuncAttributeMaxDynamicSharedMemorySize, LDS_BYTES);
        (void)hipFuncSetAttribute((const void*)k_mixD_sample, hipFuncAttributeMaxDynamicSharedMemorySize, LDS_BYTES);
        ok = 1;
    }
    if (ok < 0) return;
    unsigned char* ws = (unsigned char*)d_ws;
    P p; memset(&p, 0, sizeof p);
    const float** f = (const float**)&p;
    for (int i = 0; i < 28; ++i) f[i] = (const float*)d_in[i];
    p.out = (float*)d_out;
    p.win_t = (bf16*)(ws + WS_WIN); p.wout_t = (bf16*)(ws + WS_WOUT); p.hb = (bf16*)(ws + WS_HB); p.mix = (bf16*)(ws + WS_MIX); p.proj = (bf16*)(ws + WS_PROJ);
    p.mixed = (float*)(ws + WS_MIXED); p.yd = (float*)(ws + WS_YD); p.states = (float*)(ws + WS_ST); p.acum = (float*)(ws + WS_AC); p.cdec = (float*)(ws + WS_CD);

    k_transpose<<<dim3(PP / 32, DM / 32, DEPTH), 256, 0, stream>>>(p.w_in, DM, IN_DIM, p.win_t, PP);
    k_transpose<<<dim3(DM / 32, DM / 32, DEPTH), 256, 0, stream>>>(p.w_out, DM, DM, p.wout_t, DM);
    k_norm0<<<512, 512, 0, stream>>>(p);
    for (int l = 0; l < DEPTH; ++l) {
        p.layer = l;
        { pg8::Gemm g; memset(&g, 0, sizeof g); g.A = p.hb; g.Bt = p.win_t + (size_t)l * PP * DM; g.M = NTOK; g.N = PP; g.K = DM;
          pg8::EpiBf16<0> E; memset(&E, 0, sizeof E); E.O = p.proj; E.ldc = PP; E.bias = nullptr; E.split_cols = 0; E.split_stride = 0; E.scale0 = 1.f;
          k_gemm<pg8::EpiBf16<0>><<<256, 512, LDS_BYTES, stream>>>(g, E); }
        k_mixA<<<256, 512, LDS_BYTES, stream>>>(p);
        k_mixB<<<640, 512, LDS_BYTES, stream>>>(p);
        k_mixC<<<512, 512, LDS_BYTES, stream>>>(p);
        k_mixD_local<<<256, 512, LDS_BYTES, stream>>>(p);
        k_scan<<<128, 512, 0, stream>>>(p);
        k_mixD_finish<<<256, 512, LDS_BYTES, stream>>>(p);
        k_mixD_sample<<<256, 512, LDS_BYTES, stream>>>(p);
        { pg8::Gemm g; memset(&g, 0, sizeof g); g.A = p.mix; g.Bt = p.wout_t + (size_t)l * DM * DM; g.M = NTOK; g.N = DM; g.K = DM;
          pg8::EpiF32 E; memset(&E, 0, sizeof E); E.C = p.mixed; E.ldc = DM; E.bias = nullptr;
          k_gemm<pg8::EpiF32><<<256, 512, LDS_BYTES, stream>>>(g, E); }
        k_post<<<512, 512, 0, stream>>>(p);
    }
}
```

```cpp
#include <hip/hip_runtime.h>
#include <cstdio>
#include <cstdint>
#include <cstring>
#include <hip/hip_cooperative_groups.h>
namespace cg = cooperative_groups;
namespace pg8 {
#define PG8_LAS __attribute__((address_space(3)))
typedef unsigned short bf16_t;
typedef short bf16x8 __attribute__((ext_vector_type(8)));
typedef float f32x4 __attribute__((ext_vector_type(4)));
typedef unsigned u32x4 __attribute__((ext_vector_type(4)));
constexpr int BM = 256, BK = 64, HALF = 128, HTB = HALF * BK * 2  , STAGE_BYTES = 8 * HTB, NXCD = 8, WGM = 8;

__host__ __device__ __forceinline__ int lds_byte(int r, int c) { const int st = (r >> 4) * 2 + (c >> 5), rr = r & 15, cc = c & 31, ob = rr * 64 + cc * 2; return st * 1024 + (ob ^ (((ob >> 9) & 1) << 5)); }
__host__ __device__ __forceinline__ void stage_rc(int b, int& R, int& C) { const int st = b / 1024, sb = b % 1024, swz = sb ^ (((sb >> 9) & 1) << 5); R = (st >> 1) * 16 + swz / 64; C = (st & 1) * 32 + (swz % 64) / 2; }
__host__ __device__ __forceinline__ int perm32(int rho) { const int n = rho >> 4, i = rho & 15; return 8 * (i >> 2) + 4 * n + (i & 3); }

struct Unit { int pm, pn; };
struct Gemm { const bf16_t* A; const bf16_t* Bt; int M, N, K; };

struct StaticOrder {
    int nM, nN, nwg, G, c;
    __host__ __device__ void init(int M, int N, int G_, int c_) { nM = M / BM; nN = N / BM; nwg = nM * nN; G = G_; c = c_; }
    __host__ __device__ bool next(int i, Unit& u) const {
        const long L = (long)i * G + c; if (L >= nwg) return false;
        int wgid = (int)L; { const int q = nwg / NXCD, r = nwg % NXCD, xcd = wgid % NXCD, off = wgid / NXCD; wgid = (xcd < r ? xcd * (q + 1) : r * (q + 1) + (xcd - r) * q) + off; }
        const int nig = WGM * nN, gid = wgid / nig, fm = gid * WGM, gsz = (nM - fm) < WGM ? (nM - fm) : WGM;
        u.pm = fm + ((wgid % nig) % gsz); u.pn = (wgid % nig) / gsz; return true;
    }
    __device__ __forceinline__ void a_ready(const Unit&) const {}
    __device__ __forceinline__ void done(const Unit&) const {}
};

__device__ __forceinline__ unsigned cvt_pk_bf16(float lo, float hi) { unsigned r; asm volatile("v_cvt_pk_bf16_f32 %0, %1, %2" : "=v"(r) : "v"(lo), "v"(hi)); return r; }
typedef float f32x2 __attribute__((ext_vector_type(2)));
__device__ __forceinline__ f32x2 gelu_pk(f32x2 v) {
    const f32x2 av = __builtin_elementwise_abs(v), d = av * 0.2316418882f + 1.0f;
    f32x2 t; t.x = __builtin_amdgcn_rcpf(d.x); t.y = __builtin_amdgcn_rcpf(d.y);
    f32x2 q = t * 0.5307027145f + (-0.7265760135f); q = q * t + 0.7107068705f; q = q * t + (-0.142248368f); q = q * t + 0.127414796f; q = q * t;
    const f32x2 s = (v * v) * (-0.72134752044f);
    f32x2 e; e.x = __builtin_amdgcn_exp2f(s.x); e.y = __builtin_amdgcn_exp2f(s.y);
    const f32x2 m = v * (q * e), r = v - m;
    f32x2 o; o.x = v.x < 0.f ? m.x : r.x; o.y = v.y < 0.f ? m.y : r.y; return o;
}

struct EpiF32 {
    static constexpr bool PERM = false, AFTER_DRAIN = false;
    float* C; int ldc; const float* bias;
    __device__ __forceinline__ void operator()(const f32x4 (&acc)[2][2][4][2], const Unit& u, int wr, int wc, int fr, int fq) const {
        const int row0 = u.pm * BM + wr * 64 + fr, col0 = u.pn * BM + wc * 32 + 4 * fq;
        f32x4 bv[2][2];
#pragma unroll
        for (int bj = 0; bj < 2; ++bj)
#pragma unroll
            for (int n = 0; n < 2; ++n) bv[bj][n] = bias ? *(const f32x4*)(bias + col0 + bj * HALF + n * 16) : (f32x4){0.f, 0.f, 0.f, 0.f};
#pragma unroll
        for (int ai = 0; ai < 2; ++ai)
#pragma unroll
            for (int m = 0; m < 4; ++m) { float* rowp = C + (size_t)(row0 + ai * HALF + m * 16) * ldc + col0;
#pragma unroll
                for (int bj = 0; bj < 2; ++bj)
#pragma unroll
                    for (int n = 0; n < 2; ++n) *(f32x4*)(rowp + bj * HALF + n * 16) = acc[ai][bj][m][n] + bv[bj][n]; }
    }
};
template <int ACT  > struct EpiBf16 {
    static constexpr bool PERM = true, AFTER_DRAIN = false; static_assert(ACT == 0 || ACT == 1, "EpiBf16: ACT is 0 (none) or 1 (gelu_pk)");
    bf16_t* O; int ldc; const float* bias; int split_cols; size_t split_stride; float scale0;
    __device__ __forceinline__ void operator()(const f32x4 (&acc)[2][2][4][2], const Unit& u, int wr, int wc, int fr, int fq) const {
        const int row0 = u.pm * BM + wr * 64 + fr; int colt = u.pn * BM; bf16_t* base = O;
        float sc = 1.f; if (split_cols) { const int t = colt / split_cols; base += (size_t)t * split_stride; colt -= t * split_cols; if (t == 0) sc = scale0; }
        const int col0 = colt + wc * 32 + 8 * fq, bcol0 = u.pn * BM + wc * 32 + 8 * fq;
        f32x4 bv[2][2];
#pragma unroll
        for (int bj = 0; bj < 2; ++bj)
#pragma unroll
            for (int n = 0; n < 2; ++n) bv[bj][n] = bias ? *(const f32x4*)(bias + bcol0 + bj * HALF + 4 * n) : (f32x4){0.f, 0.f, 0.f, 0.f};
#pragma unroll
        for (int ai = 0; ai < 2; ++ai)
#pragma unroll
            for (int m = 0; m < 4; ++m) { bf16_t* rowp = base + (size_t)(row0 + ai * HALF + m * 16) * ldc + col0;
#pragma unroll
                for (int bj = 0; bj < 2; ++bj) { f32x4 v0 = acc[ai][bj][m][0] + bv[bj][0], v1 = acc[ai][bj][m][1] + bv[bj][1];
                    if (ACT == 1) { f32x2 a = gelu_pk((f32x2){v0[0], v0[1]}), b = gelu_pk((f32x2){v0[2], v0[3]}), c = gelu_pk((f32x2){v1[0], v1[1]}), d = gelu_pk((f32x2){v1[2], v1[3]});
                        v0 = (f32x4){a.x, a.y, b.x, b.y}; v1 = (f32x4){c.x, c.y, d.x, d.y}; }
                    v0 = v0 * sc; v1 = v1 * sc; u32x4 w; w.x = cvt_pk_bf16(v0[0], v0[1]); w.y = cvt_pk_bf16(v0[2], v0[3]); w.z = cvt_pk_bf16(v1[0], v1[1]); w.w = cvt_pk_bf16(v1[2], v1[3]);
                    *(u32x4*)(rowp + bj * HALF) = w; } }
    }
};

struct PanelStats {
    unsigned* xbuf;
    unsigned* cnt;
    unsigned* tmo;
    int ntn; float eps;
    unsigned code;
    __device__ __forceinline__ bool run(const f32x4 (&v)[2][2][4][2], const Unit& u, int wr, int wc, int fr, int fq, PG8_LAS unsigned char* lds, int wid, int lane) const {
        typedef float f32x2v __attribute__((ext_vector_type(2)));
        PG8_LAS f32x2v* P = (PG8_LAS f32x2v*)lds;
        PG8_LAS f32x2v* S = (PG8_LAS f32x2v*)(lds + 8192);
        PG8_LAS unsigned* flag = (PG8_LAS unsigned*)(lds + 8192 + 2048);
#pragma unroll
        for (int ai = 0; ai < 2; ++ai)
#pragma unroll
            for (int m = 0; m < 4; ++m) {
                float s = 0.f;
#pragma unroll
                for (int bj = 0; bj < 2; ++bj)
#pragma unroll
                    for (int n = 0; n < 2; ++n) { const f32x4 x = v[ai][bj][m][n]; s += (x[0] + x[1]) + (x[2] + x[3]); }
                s += __shfl_xor(s, 16); s += __shfl_xor(s, 32);
                const float mw = s * (1.0f / 64.0f); float q = 0.f;
#pragma unroll
                for (int bj = 0; bj < 2; ++bj)
#pragma unroll
                    for (int n = 0; n < 2; ++n) { const f32x4 d = v[ai][bj][m][n] - mw; q += (d[0] * d[0] + d[1] * d[1]) + (d[2] * d[2] + d[3] * d[3]); }
                q += __shfl_xor(q, 16); q += __shfl_xor(q, 32);
                if (fq == 0) P[(ai * HALF + wr * 64 + m * 16 + fr) * 4 + wc] = (f32x2v){mw, q};
            }
        asm volatile("s_waitcnt lgkmcnt(0)" ::: "memory"); __builtin_amdgcn_s_barrier(); asm volatile("" ::: "memory");
#if defined(BROKEN_EXCHANGE_NO_WAIT)
#warning BROKEN CONTROL BUILD: the row-statistics exchange does not wait; results are wrong by design
        if (blockIdx.x >= 64) { const long long t0_ = clock64(); while (clock64() - t0_ < 60000) __builtin_amdgcn_s_sleep(8); }
#endif
        const int row = wid * 32 + (lane & 31);
        if (lane < 32) {
            const f32x2v a = P[row * 4 + 0], b = P[row * 4 + 1], c = P[row * 4 + 2], d = P[row * 4 + 3];
            const float mt = (a.x + b.x + c.x + d.x) * 0.25f;
            const float da = a.x - mt, db = b.x - mt, dc = c.x - mt, dd = d.x - mt;
            const float m2 = (a.y + b.y) + (c.y + d.y) + 64.0f * ((da * da + db * db) + (dc * dc + dd * dd));
            unsigned long long* slot = (unsigned long long*)xbuf + ((size_t)(u.pm * BM + row) * 4 + u.pn);
            __hip_atomic_store(slot, ((unsigned long long)__float_as_uint(m2) << 32) | __float_as_uint(mt), __ATOMIC_RELAXED, __HIP_MEMORY_SCOPE_AGENT);
        }
        asm volatile("s_waitcnt vmcnt(0)" ::: "memory");
        if (lane == 0) __hip_atomic_fetch_add(cnt + 64 * u.pm, 1u, __ATOMIC_RELAXED, __HIP_MEMORY_SCOPE_AGENT);
        if (wid == 0) {
            bool dead = false; const unsigned long long t0 = __builtin_amdgcn_s_memrealtime(); const unsigned want = 8u * (unsigned)ntn;
            for (;;) {
#if defined(BROKEN_EXCHANGE_NO_WAIT)
                break;
#endif
                if ((unsigned)__builtin_amdgcn_readfirstlane(__hip_atomic_load(cnt + 64 * u.pm, __ATOMIC_RELAXED, __HIP_MEMORY_SCOPE_AGENT)) >= want) break;
                if (__builtin_amdgcn_s_memrealtime() - t0 > 2000000ull) {
                    if (lane == 0) { unsigned expect = 0u; __hip_atomic_compare_exchange_strong(tmo + 1, &expect, code | (unsigned)(u.pm & 0xff), __ATOMIC_RELAXED, __ATOMIC_RELAXED, __HIP_MEMORY_SCOPE_AGENT);
                                     __hip_atomic_store(tmo, 1u, __ATOMIC_RELAXED, __HIP_MEMORY_SCOPE_AGENT); }
                    dead = true; break; }
                __builtin_amdgcn_s_sleep(2);
            }
            __builtin_amdgcn_fence(__ATOMIC_ACQUIRE, "agent");
            if (lane == 0) flag[0] = dead ? 1u : 0u;
        }
        asm volatile("s_waitcnt vmcnt(0) lgkmcnt(0)" ::: "memory"); __builtin_amdgcn_s_barrier(); asm volatile("" ::: "memory");
        const bool bad = flag[0] != 0u;
        if (lane < 32) {
            const unsigned long long* slot = (const unsigned long long*)xbuf + (size_t)(u.pm * BM + row) * 4; float mt[4], m2[4]; float ms = 0.f;
#pragma unroll
            for (int t = 0; t < 4; ++t) { if (t < ntn) { const unsigned long long w = __hip_atomic_load(slot + t, __ATOMIC_RELAXED, __HIP_MEMORY_SCOPE_AGENT); mt[t] = __uint_as_float((unsigned)w); m2[t] = __uint_as_float((unsigned)(w >> 32)); } else { mt[t] = 0.f; m2[t] = 0.f; } ms += mt[t]; }
            const float mean = ms / (float)ntn; float q = 0.f;
#pragma unroll
            for (int t = 0; t < 4; ++t) if (t < ntn) { const float dm = mt[t] - mean; q += m2[t] + 256.0f * dm * dm; }
            S[row] = (f32x2v){mean, 1.0f / sqrtf(q / (256.0f * (float)ntn) + eps)};
        }
        asm volatile("s_waitcnt lgkmcnt(0)" ::: "memory"); __builtin_amdgcn_s_barrier(); asm volatile("" ::: "memory");
        return bad;
    }
};
struct EpiLnRes {
    static constexpr bool PERM = false, AFTER_DRAIN = true;
    const float* base; float* out; int ldc; const float* bias; PanelStats st; unsigned poison;
    __device__ __forceinline__ void fused(f32x4 (&acc)[2][2][4][2], const Unit& u, int wr, int wc, int fr, int fq, PG8_LAS unsigned char* lds, int wid, int lane) const {
        typedef float f32x2v __attribute__((ext_vector_type(2)));
        const PG8_LAS f32x2v* S = (const PG8_LAS f32x2v*)(lds + 8192);
        const int col0 = u.pn * BM + wc * 32 + 4 * fq;
#pragma unroll
        for (int bj = 0; bj < 2; ++bj)
#pragma unroll
            for (int n = 0; n < 2; ++n) { const f32x4 bv = bias ? *(const f32x4*)(bias + col0 + bj * HALF + n * 16) : (f32x4){0.f, 0.f, 0.f, 0.f};
#pragma unroll
                for (int ai = 0; ai < 2; ++ai)
#pragma unroll
                    for (int m = 0; m < 4; ++m) acc[ai][bj][m][n] += bv; }
        f32x4 pre[4][2][2];
#pragma unroll
        for (int m = 0; m < 4; ++m) { const size_t off = (size_t)(u.pm * BM + wr * 64 + m * 16 + fr) * ldc + col0;
#pragma unroll
            for (int bj = 0; bj < 2; ++bj)
#pragma unroll
                for (int n = 0; n < 2; ++n) pre[m][bj][n] = *(const f32x4*)(base + off + bj * HALF + n * 16); }
        const bool bad = st.run(acc, u, wr, wc, fr, fq, lds, wid, lane) || poison != 0u;
        const float qnan = __builtin_nanf("");
#pragma unroll
        for (int ai = 0; ai < 2; ++ai)
#pragma unroll
            for (int m = 0; m < 4; ++m) { const int r = ai * HALF + wr * 64 + m * 16 + fr; const f32x2v sr = S[r]; const size_t off = (size_t)(u.pm * BM + r) * ldc + col0;
#pragma unroll
                for (int bj = 0; bj < 2; ++bj)
#pragma unroll
                    for (int n = 0; n < 2; ++n) { const f32x4 bs = ai == 0 ? pre[m][bj][n] : *(const f32x4*)(base + off + bj * HALF + n * 16); f32x4 o = bs + (acc[ai][bj][m][n] - sr.x) * sr.y;
                        if (bad) o = (f32x4){qnan, qnan, qnan, qnan}; *(f32x4*)(out + off + bj * HALF + n * 16) = o; }
                if (m & 1) asm volatile("" ::: "memory"); }
    }
};
struct EpiLnResLn {
    static constexpr bool PERM = false, AFTER_DRAIN = true;
    const float* base; float* out; bf16_t* xn; int ldc; const float* bias; PanelStats st1, st2; unsigned poison;
    __device__ __forceinline__ void fused(f32x4 (&acc)[2][2][4][2], const Unit& u, int wr, int wc, int fr, int fq, PG8_LAS unsigned char* lds, int wid, int lane) const {
        typedef float f32x2v __attribute__((ext_vector_type(2))); typedef unsigned u32x2v __attribute__((ext_vector_type(2)));
        const PG8_LAS f32x2v* S = (const PG8_LAS f32x2v*)(lds + 8192);
        const int col0 = u.pn * BM + wc * 32 + 4 * fq;
#pragma unroll
        for (int bj = 0; bj < 2; ++bj)
#pragma unroll
            for (int n = 0; n < 2; ++n) { const f32x4 bv = bias ? *(const f32x4*)(bias + col0 + bj * HALF + n * 16) : (f32x4){0.f, 0.f, 0.f, 0.f};
#pragma unroll
                for (int ai = 0; ai < 2; ++ai)
#pragma unroll
                    for (int m = 0; m < 4; ++m) acc[ai][bj][m][n] += bv; }
        bool bad = st1.run(acc, u, wr, wc, fr, fq, lds, wid, lane) || poison != 0u;
        const float qnan = __builtin_nanf("");
#pragma unroll
        for (int ai = 0; ai < 2; ++ai)
#pragma unroll
            for (int m = 0; m < 4; ++m) { const int r = ai * HALF + wr * 64 + m * 16 + fr; const f32x2v sr = S[r]; const size_t off = (size_t)(u.pm * BM + r) * ldc + col0;
#pragma unroll
                for (int bj = 0; bj < 2; ++bj)
#pragma unroll
                    for (int n = 0; n < 2; ++n) { const f32x4 bs = *(const f32x4*)(base + off + bj * HALF + n * 16); acc[ai][bj][m][n] = bs + (acc[ai][bj][m][n] - sr.x) * sr.y; }
                asm volatile("" : "+v"(acc[ai][0][m][0]), "+v"(acc[ai][0][m][1]), "+v"(acc[ai][1][m][0]), "+v"(acc[ai][1][m][1]));
                if (m & 1) asm volatile("" ::: "memory"); }
        const bool bad1 = bad;
        bad = st2.run(acc, u, wr, wc, fr, fq, lds, wid, lane) || bad;
#pragma unroll
        for (int ai = 0; ai < 2; ++ai)
#pragma unroll
            for (int m = 0; m < 4; ++m) { const int r = ai * HALF + wr * 64 + m * 16 + fr; const f32x2v sr = S[r]; const size_t off = (size_t)(u.pm * BM + r) * ldc + col0;
#pragma unroll
                for (int bj = 0; bj < 2; ++bj)
#pragma unroll
                    for (int n = 0; n < 2; ++n) { const f32x4 x1 = acc[ai][bj][m][n]; *(f32x4*)(out + off + bj * HALF + n * 16) = bad1 ? (f32x4){qnan, qnan, qnan, qnan} : x1;
                        const f32x4 o = (x1 - sr.x) * sr.y; u32x2v w; w.x = cvt_pk_bf16(o[0], o[1]); w.y = cvt_pk_bf16(o[2], o[3]);
                        if (bad) { w.x = 0x7fc07fc0u; w.y = 0x7fc07fc0u; } *(u32x2v*)(xn + off + bj * HALF + n * 16) = w; }
                asm volatile("" ::: "memory"); }
    }
};

template <class Epi, class Sched, bool ALIGN_EPI = false, bool SP2 = false>
__device__ __forceinline__ void gemm_phase(PG8_LAS unsigned char* lds, const Gemm g, const Sched& S, const Epi& E) {
    const int tid = threadIdx.x, wid = __builtin_amdgcn_readfirstlane(tid >> 6), lane = tid & 63, wr = wid >> 2, wc = wid & 3, fr = lane & 15, fq = lane >> 4;
    const int K = g.K, nt = K / BK;
    unsigned voffA[2], voffB[2];
#pragma unroll
    for (int i = 0; i < 2; ++i) { int R, C; stage_rc(tid * 16 + i * 8192, R, C); const int Rb = Epi::PERM ? ((R & ~31) + perm32(R & 31)) : R;
        voffA[i] = (unsigned)(R * K + C) * 2u; voffB[i] = (unsigned)(Rb * K + C) * 2u; }
    const size_t kstep = (size_t)(BK * 2);
    const size_t hstep = (size_t)HALF * K * 2;
    const size_t tstep = 2 * hstep;
    const unsigned ldsw = (unsigned)wid * 1024u;
    const int aoff = lds_byte(wr * 64 + fr, fq * 8), boff = lds_byte(wc * 32 + fr, fq * 8);
#define PG8_SA(b, h) (((b) * 2 + (h)) * HTB)
#define PG8_SB(b, h) ((4 + (b) * 2 + (h)) * HTB)
#define PG8_STAGE(bufoff, gbase, voff) do { _Pragma("unroll") for (int _i = 0; _i < 2; ++_i) \
        __builtin_amdgcn_global_load_lds((const unsigned*)((const char*)(gbase) + (voff)[_i]), (PG8_LAS unsigned*)(lds + (bufoff) + ldsw + _i * 8192), 16, 0, 0); } while (0)
#define PG8_LDA(dst, b, h) do { _Pragma("unroll") for (int m = 0; m < 4; ++m) _Pragma("unroll") for (int k = 0; k < 2; ++k) dst[m][k] = *(const PG8_LAS bf16x8*)(lds + PG8_SA(b, h) + aoff + m * 2048 + k * 1024); } while (0)
#define PG8_LDB(dst, b, h) do { _Pragma("unroll") for (int n = 0; n < 2; ++n) _Pragma("unroll") for (int k = 0; k < 2; ++k) dst[n][k] = *(const PG8_LAS bf16x8*)(lds + PG8_SB(b, h) + boff + n * 2048 + k * 1024); } while (0)
#define PG8_MMA(ai, bj, At, Bt) do { __builtin_amdgcn_s_setprio(1); _Pragma("unroll") for (int m = 0; m < 4; ++m) _Pragma("unroll") for (int n = 0; n < 2; ++n) _Pragma("unroll") for (int k = 0; k < 2; ++k) \
        acc[ai][bj][m][n] = __builtin_amdgcn_mfma_f32_16x16x32_bf16(Bt[n][k], At[m][k], acc[ai][bj][m][n], 0, 0, 0); __builtin_amdgcn_s_setprio(0); } while (0)
#define PG8_WAIT_V(n) asm volatile("s_waitcnt vmcnt(" #n ")" ::: "memory")
#define PG8_WAIT_L(n) asm volatile("s_waitcnt lgkmcnt(" #n ")" ::: "memory")
#define PG8_BAR __builtin_amdgcn_s_barrier()
#define PG8_SCHED __builtin_amdgcn_sched_barrier(0)
    Unit cur, nxt; int ui = 0;
    if (!S.next(0, cur)) return;
    f32x4 acc[2][2][4][2];
#pragma unroll
    for (int a = 0; a < 2; ++a)
#pragma unroll
        for (int b = 0; b < 2; ++b)
#pragma unroll
            for (int m = 0; m < 4; ++m)
#pragma unroll
                for (int n = 0; n < 2; ++n) acc[a][b][m][n] = (f32x4){0.f, 0.f, 0.f, 0.f};
    bf16x8 At[4][2], B0[2][2], B1[2][2];
    const char* cA = (const char*)g.A + (size_t)cur.pm * tstep; const char* cB = (const char*)g.Bt + (size_t)cur.pn * tstep;
    S.a_ready(cur);
    if constexpr (SP2) {
        PG8_STAGE(PG8_SB(0, 0), cB, voffB); PG8_STAGE(PG8_SB(0, 1), cB + hstep, voffB); PG8_STAGE(PG8_SA(0, 0), cA, voffA); PG8_STAGE(PG8_SA(0, 1), cA + hstep, voffA);
        if (wr == 1) PG8_BAR;
        PG8_WAIT_V(2); PG8_BAR;
        PG8_STAGE(PG8_SB(1, 0), cB + kstep, voffB); PG8_STAGE(PG8_SA(1, 0), cA + kstep, voffA); PG8_STAGE(PG8_SB(1, 1), cB + hstep + kstep, voffB);
        PG8_WAIT_V(6); PG8_BAR;
    } else {
        PG8_STAGE(PG8_SB(0, 0), cB, voffB); PG8_STAGE(PG8_SA(0, 0), cA, voffA); PG8_STAGE(PG8_SB(0, 1), cB + hstep, voffB); PG8_STAGE(PG8_SA(0, 1), cA + hstep, voffA);
        if (wr == 1) PG8_BAR;
        PG8_WAIT_V(4); PG8_BAR;
        PG8_STAGE(PG8_SB(1, 0), cB + kstep, voffB); PG8_STAGE(PG8_SA(1, 0), cA + kstep, voffA); PG8_STAGE(PG8_SB(1, 1), cB + hstep + kstep, voffB);
        PG8_WAIT_V(6); PG8_BAR;
    }
    for (;;) {
        const bool has_next = S.next(ui + 1, nxt);
        const char* nA = has_next ? (const char*)g.A + (size_t)nxt.pm * tstep : cA; const char* nB = has_next ? (const char*)g.Bt + (size_t)nxt.pn * tstep : cB;
        for (int t = 0; t < nt; t += 2) {
            const bool last = (t == nt - 2);
            const char* a1 = cA + (size_t)(t + 1) * kstep;
            const char* a2 = last ? nA : cA + (size_t)(t + 2) * kstep; const char* b2 = last ? nB : cB + (size_t)(t + 2) * kstep;
            const char* a3 = a2 + kstep; const char* b3 = b2 + kstep;
            if (last && has_next) S.a_ready(nxt);
            if constexpr (SP2) {
            PG8_LDB(B0, 0, 0); PG8_LDB(B1, 0, 1); PG8_SCHED; PG8_LDA(At, 0, 0); PG8_STAGE(PG8_SA(1, 1), a1 + hstep, voffA);
            PG8_WAIT_V(8); PG8_WAIT_L(0); PG8_BAR; PG8_MMA(0, 0, At, B0); PG8_MMA(0, 1, At, B1); PG8_BAR; PG8_SCHED;
            PG8_LDA(At, 0, 1); PG8_STAGE(PG8_SB(0, 0), b2, voffB); PG8_STAGE(PG8_SB(0, 1), b2 + hstep, voffB); PG8_STAGE(PG8_SA(0, 0), a2, voffA);
            PG8_WAIT_V(8); PG8_WAIT_L(0); PG8_BAR; PG8_MMA(1, 0, At, B0); PG8_MMA(1, 1, At, B1); PG8_BAR; PG8_SCHED;
            PG8_LDB(B0, 1, 0); PG8_LDB(B1, 1, 1); PG8_SCHED; PG8_LDA(At, 1, 0); PG8_STAGE(PG8_SA(0, 1), a2 + hstep, voffA);
            PG8_WAIT_V(8); PG8_WAIT_L(0); PG8_BAR; PG8_MMA(0, 0, At, B0); PG8_MMA(0, 1, At, B1); PG8_BAR; PG8_SCHED;
            PG8_LDA(At, 1, 1); PG8_STAGE(PG8_SB(1, 0), b3, voffB); PG8_STAGE(PG8_SB(1, 1), b3 + hstep, voffB); PG8_STAGE(PG8_SA(1, 0), a3, voffA);
            PG8_WAIT_V(8); PG8_WAIT_L(0); PG8_BAR; PG8_MMA(1, 0, At, B0); PG8_MMA(1, 1, At, B1); PG8_BAR; PG8_SCHED;
            } else {
            PG8_LDB(B0, 0, 0); PG8_SCHED; PG8_LDA(At, 0, 0); PG8_STAGE(PG8_SA(1, 1), a1 + hstep, voffA);
            PG8_WAIT_L(8); PG8_BAR; PG8_WAIT_L(0); PG8_MMA(0, 0, At, B0); PG8_BAR; PG8_SCHED;
            PG8_LDB(B1, 0, 1); PG8_STAGE(PG8_SB(0, 0), b2, voffB);
            PG8_BAR; PG8_WAIT_L(0); PG8_MMA(0, 1, At, B1); PG8_BAR;
            PG8_LDA(At, 0, 1); PG8_STAGE(PG8_SA(0, 0), a2, voffA);
            PG8_BAR; PG8_WAIT_L(0); PG8_MMA(1, 0, At, B0); PG8_BAR; PG8_SCHED;
            PG8_STAGE(PG8_SB(0, 1), b2 + hstep, voffB);
            PG8_WAIT_V(6); PG8_BAR; PG8_MMA(1, 1, At, B1); PG8_BAR;
            PG8_LDB(B0, 1, 0); PG8_SCHED; PG8_LDA(At, 1, 0); PG8_STAGE(PG8_SA(0, 1), a2 + hstep, voffA);
            PG8_WAIT_L(8); PG8_BAR; PG8_WAIT_L(0); PG8_MMA(0, 0, At, B0); PG8_BAR; PG8_SCHED;
            PG8_LDB(B1, 1, 1); PG8_STAGE(PG8_SB(1, 0), b3, voffB);
            PG8_BAR; PG8_WAIT_L(0); PG8_MMA(0, 1, At, B1); PG8_BAR;
            PG8_LDA(At, 1, 1); PG8_STAGE(PG8_SA(1, 0), a3, voffA);
            PG8_BAR; PG8_WAIT_L(0); PG8_MMA(1, 0, At, B0); PG8_BAR; PG8_SCHED;
            PG8_STAGE(PG8_SB(1, 1), b3 + hstep, voffB);
            PG8_WAIT_V(6); PG8_BAR; PG8_MMA(1, 1, At, B1); PG8_BAR;
            }
        }
        if constexpr (ALIGN_EPI) { if (wr == 0) PG8_BAR; }
        if constexpr (!Epi::AFTER_DRAIN) { E(acc, cur, wr, wc, fr, fq); S.done(cur); }
        if (!has_next) break;
#pragma unroll
        for (int a = 0; a < 2; ++a)
#pragma unroll
            for (int b = 0; b < 2; ++b)
#pragma unroll
                for (int m = 0; m < 4; ++m)
#pragma unroll
                    for (int n = 0; n < 2; ++n) acc[a][b][m][n] = (f32x4){0.f, 0.f, 0.f, 0.f};
        cur = nxt; cA = nA; cB = nB; ++ui;
        if constexpr (ALIGN_EPI) { if (wr == 1) PG8_BAR; }
    }
    PG8_WAIT_V(0);
    if constexpr (!ALIGN_EPI) { if (wr == 0) PG8_BAR; }
    PG8_BAR;
    if constexpr (Epi::AFTER_DRAIN) { E.fused(acc, cur, wr, wc, fr, fq, lds, wid, lane); S.done(cur); }
#undef PG8_SA
#undef PG8_SB
#undef PG8_STAGE
#undef PG8_LDA
#undef PG8_LDB
#undef PG8_MMA
#undef PG8_WAIT_V
#undef PG8_WAIT_L
#undef PG8_BAR
#undef PG8_SCHED
}
}

typedef unsigned short bf16;
constexpr int DM = 1024, SEQ = 8192, NB = 2, DEPTH = 4, SB = 128, SL = 8;
constexpr int NP = NB * SEQ;
constexpr int NS = SB * SL;
constexpr int NTOK = NP + NS;
constexpr int IN_DIM = 3332, PP = 3584;
constexpr int AU = 0, AV = 256, AZ = 512, BV = 768, BG = 1024, BZ = 1280, CQ = 1536, CK = 1792, CV = 1920, CZ = 2048, DZ = 2304, DX = 2560, DT = 3328;
constexpr float EPS = 1e-6f;
constexpr size_t O_YP = 0, O_YS = O_YP + (size_t)NP * DM, O_KP = O_YS + (size_t)NS * DM, O_KS = O_KP + 4 * 2 * 128 * 128, O_VP = O_KS + 4 * 128 * 8 * 128,
                 O_VS = O_VP + 4 * 2 * 128 * 128, O_CBP = O_VS + 4 * 128 * 8 * 128, O_CBS = O_CBP + 4 * 2 * 30 * 256, O_CDP = O_CBS + 4 * 128 * 8 * 256,
                 O_CDS = O_CDP + 4 * 2 * 3 * 768, O_SSP = O_CDS + (size_t)4 * 128 * 8 * 768, O_SSS = O_SSP + 4 * 2 * 4 * 64 * 128, O_AV = O_SSS + (size_t)4 * 128 * 4 * 64 * 128,
                 O_END = O_AV + 4 * 128 * 8 * 256;
constexpr size_t MiB = 1u << 20;
constexpr size_t WS_CTL = 0, WS_WIN = 2 * MiB, WS_WOUT = 30 * MiB, WS_PW = 38 * MiB, WS_HB = 40 * MiB, WS_MIX = 74 * MiB, WS_PROJ = 108 * MiB, WS_MIXED = WS_PROJ,
                 WS_YD = 227 * MiB, WS_ST = 243 * MiB, WS_AC = 259 * MiB, WS_CD = WS_AC + 512 * 1024, WS_END = 260 * MiB;
static_assert(WS_WIN + (size_t)DEPTH * PP * DM * 2 <= WS_WOUT && WS_HB + (size_t)NTOK * DM * 2 <= WS_MIX && WS_MIX + (size_t)NTOK * DM * 2 <= WS_PROJ &&
              WS_PROJ + (size_t)NTOK * PP * 2 <= WS_YD && WS_MIXED + (size_t)NTOK * DM * 4 <= WS_YD, "ws map");

struct P {
    const float *x_prompt, *x_sample, *cache_k, *cache_v, *st_conv_b, *st_conv_d, *st_ssm, *norm_pre, *norm_post, *w_in, *w_out, *a_ln_g, *a_ln_b, *a_ws, *a_wb,
        *b_conv_w, *b_conv_b, *b_ln_g, *b_ln_b, *b_pw_w, *b_pw_b, *c_sinks, *d_conv_w, *d_conv_b, *d_dt_bias, *d_a_log, *d_skip, *d_norm_g;
    float* out;
    bf16 *win_t, *wout_t, *hb, *mix, *proj;
    float *mixed, *yd, *states, *acum, *cdec;
    int layer, pad;
};

typedef const P __attribute__((address_space(4)))* PCP;
__device__ __forceinline__ PCP getp() { PCP q = (PCP)__builtin_amdgcn_kernarg_segment_ptr(); asm volatile("" : "+s"(q)); return q; }
__device__ __forceinline__ float bf2f(bf16 v) { return __uint_as_float((unsigned)v << 16); }
__device__ __forceinline__ bf16 f2bf(float f) { unsigned u = __float_as_uint(f); return (bf16)((u + 0x7fffu + ((u >> 16) & 1u)) >> 16); }
__device__ __forceinline__ float sigmoid_(float x) { return 1.f / (1.f + __expf(-x)); }
__device__ __forceinline__ float silu_(float x) { return x / (1.f + __expf(-x)); }
__device__ __forceinline__ float gelu_(float x) { const float u = 0.7978845608028654f * (x + 0.044715f * x * x * x); return x / (1.f + __expf(-2.f * u)); }
__device__ __forceinline__ float softplus_(float x) { return x > 20.f ? x : log1pf(__expf(x)); }
__device__ __forceinline__ int tid_() { int t = threadIdx.x; asm volatile("" : "+v"(t)); return t; }
__device__ __forceinline__ float wave_sum(float v) {
#pragma unroll
    for (int o = 1; o < 64; o <<= 1) v += __shfl_xor(v, o);
    return v;
}


__device__ __forceinline__ void norm0_phase(const PCP p) {
    const int tid = tid_(), lane = tid & 63, gw = blockIdx.x * 8 + (tid >> 6), ngw = gridDim.x * 8;
    for (int r = gw; r < NTOK; r += ngw) {
        const float* src = r < NP ? p->x_prompt + (size_t)r * DM : p->x_sample + (size_t)(r - NP) * DM;
        float4 v[4]; float ss = 0.f;
#pragma unroll
        for (int j = 0; j < 4; ++j) { v[j] = ((const float4*)src)[lane + 64 * j]; ss += v[j].x * v[j].x + v[j].y * v[j].y + v[j].z * v[j].z + v[j].w * v[j].w; }
        const float rstd = rsqrtf(wave_sum(ss) * (1.f / DM) + EPS);
#pragma unroll
        for (int j = 0; j < 4; ++j) {
            ((float4*)(p->out + (size_t)r * DM))[lane + 64 * j] = v[j];
            const float4 g = ((const float4*)p->norm_pre)[lane + 64 * j];
            ushort4 o; o.x = f2bf(v[j].x * rstd * g.x); o.y = f2bf(v[j].y * rstd * g.y); o.z = f2bf(v[j].z * rstd * g.z); o.w = f2bf(v[j].w * rstd * g.w);
            ((ushort4*)(p->hb + (size_t)r * DM))[lane + 64 * j] = o;
        }
    }
}
__device__ __forceinline__ void post_phase(const PCP p, const int l) {
    const int tid = tid_(), lane = tid & 63, gw = blockIdx.x * 8 + (tid >> 6), ngw = gridDim.x * 8;
    for (int r = gw; r < NTOK; r += ngw) {
        float4 m[4], x[4]; float ss = 0.f;
#pragma unroll
        for (int j = 0; j < 4; ++j) { m[j] = ((const float4*)(p->mixed + (size_t)r * DM))[lane + 64 * j]; ss += m[j].x * m[j].x + m[j].y * m[j].y + m[j].z * m[j].z + m[j].w * m[j].w; }
        const float rstd = rsqrtf(wave_sum(ss) * (1.f / DM) + EPS);
        float sx = 0.f;
#pragma unroll
        for (int j = 0; j < 4; ++j) {
            x[j] = ((const float4*)(p->out + (size_t)r * DM))[lane + 64 * j];
            const float4 g = ((const float4*)(p->norm_post + l * DM))[lane + 64 * j];
            x[j].x += m[j].x * rstd * g.x; x[j].y += m[j].y * rstd * g.y; x[j].z += m[j].z * rstd * g.z; x[j].w += m[j].w * rstd * g.w;
            sx += x[j].x * x[j].x + x[j].y * x[j].y + x[j].z * x[j].z + x[j].w * x[j].w;
            ((float4*)(p->out + (size_t)r * DM))[lane + 64 * j] = x[j];
        }
        if (l + 1 < DEPTH) {
            const float rx = rsqrtf(wave_sum(sx) * (1.f / DM) + EPS);
#pragma unroll
            for (int j = 0; j < 4; ++j) {
                const float4 g = ((const float4*)(p->norm_pre + (l + 1) * DM))[lane + 64 * j];
                ushort4 o; o.x = f2bf(x[j].x * rx * g.x); o.y = f2bf(x[j].y * rx * g.y); o.z = f2bf(x[j].z * rx * g.z); o.w = f2bf(x[j].w * rx * g.w);
                ((ushort4*)(p->hb + (size_t)r * DM))[lane + 64 * j] = o;
            }
        }
    }
}


__device__ __forceinline__ void mixA_item(const PCP p, const int l, int item, float* lds) {
    const int tid = tid_(), lane = tid & 63, wave = tid >> 6;
    const bool sample = item >= 128;
    const int q = sample ? 8 : 128, row0 = sample ? NP + (item - 128) * 8 : item * 128;
    const float* lng = p->a_ln_g + l * 256; const float* lnb = p->a_ln_b + l * 256;
    for (int t = wave; t < q; t += 8) {
        const bf16* pr = p->proj + (size_t)(row0 + t) * PP + AV + lane * 4;
        const ushort4 raw = *(const ushort4*)pr;
        float g[4] = {gelu_(bf2f(raw.x)), gelu_(bf2f(raw.y)), gelu_(bf2f(raw.z)), gelu_(bf2f(raw.w))};
        const float mean = wave_sum(g[0] + g[1] + g[2] + g[3]) * (1.f / 256.f);
        float d2 = 0.f;
#pragma unroll
        for (int k = 0; k < 4; ++k) { g[k] -= mean; d2 += g[k] * g[k]; }
        const float rstd = rsqrtf(wave_sum(d2) * (1.f / 256.f) + EPS);
#pragma unroll
        for (int k = 0; k < 4; ++k) {
            const float v = g[k] * rstd * lng[lane * 4 + k] + lnb[lane * 4 + k];
            lds[t * 256 + lane * 4 + k] = v;
            if (sample) p->out[O_AV + ((size_t)(l * 128 + (item - 128)) * 8 + t) * 256 + lane * 4 + k] = v;
        }
    }
    __syncthreads();
    const int c = tid & 255, th = tid >> 8, h = c >> 6;
    const float* W = p->a_ws + (size_t)(l * 4 + h) * 128 * 128; const float* wb = p->a_wb + (l * 4 + h) * 128;
    for (int t = th; t < q; t += 2) {
        float acc = 0.f; const float* wr = W + t * 128;
        for (int s = 0; s <= t; ++s) acc += wr[s] * lds[s * 256 + c];
        acc += wb[t];
        const bf16* pr = p->proj + (size_t)(row0 + t) * PP;
        const float u = gelu_(bf2f(pr[AU + c])), z = bf2f(pr[AZ + c]);
        p->mix[(size_t)(row0 + t) * DM + c] = f2bf(u * acc * silu_(z));
    }
    __syncthreads();
}

__device__ __forceinline__ void mixB_item(const PCP p, const int l, int item, float* lds) {
    const int tid = tid_(), lane = tid & 63, wave = tid >> 6;
    float* glu = lds; float* cln = lds + 62 * 256;
    const bool sample = item >= 512;
    const int nt = sample ? 8 : 32, b = sample ? 0 : item >> 8, t0 = sample ? 0 : (item & 255) * 32, n = item - 512;
    const int row0 = sample ? NP + n * 8 : b * SEQ + t0;
    for (int j = wave; j < nt + 30; j += 8) {
        float g[4] = {0.f, 0.f, 0.f, 0.f};
        int srow = -1;
        if (!sample) { const int t = t0 - 30 + j; if (t >= 0) srow = b * SEQ + t; }
        else { if (j >= 30) srow = row0 + j - 30; else { const float4 s4 = *(const float4*)(p->st_conv_b + ((size_t)(l * 128 + n) * 30 + j) * 256 + lane * 4); g[0] = s4.x; g[1] = s4.y; g[2] = s4.z; g[3] = s4.w; } }
        if (srow >= 0) {
            const ushort4 v = *(const ushort4*)(p->proj + (size_t)srow * PP + BV + lane * 4);
            const ushort4 gg = *(const ushort4*)(p->proj + (size_t)srow * PP + BG + lane * 4);
            g[0] = bf2f(v.x) * sigmoid_(bf2f(gg.x)); g[1] = bf2f(v.y) * sigmoid_(bf2f(gg.y)); g[2] = bf2f(v.z) * sigmoid_(bf2f(gg.z)); g[3] = bf2f(v.w) * sigmoid_(bf2f(gg.w));
        }
#pragma unroll
        for (int k = 0; k < 4; ++k) glu[j * 256 + lane * 4 + k] = g[k];
        if (sample && j >= 30) *(float4*)(p->out + O_CBS + ((size_t)(l * 128 + n) * 8 + (j - 30)) * 256 + lane * 4) = make_float4(g[0], g[1], g[2], g[3]);
        if (!sample) { const int t = t0 - 30 + j; if (t >= SEQ - 30) *(float4*)(p->out + O_CBP + ((size_t)(l * 2 + b) * 30 + (t - (SEQ - 30))) * 256 + lane * 4) = make_float4(g[0], g[1], g[2], g[3]); }
    }
    __syncthreads();
    for (int t = wave; t < nt; t += 8) {
        float c[4];
#pragma unroll
        for (int k = 0; k < 4; ++k) c[k] = p->b_conv_b[l * 256 + lane * 4 + k];
#pragma unroll 1
        for (int j = 0; j < 31; ++j) {
            const float4 w = *(const float4*)(p->b_conv_w + (size_t)(l * 31 + j) * 256 + lane * 4);
            const float* gr = glu + (t + j) * 256 + lane * 4;
            c[0] += w.x * gr[0]; c[1] += w.y * gr[1]; c[2] += w.z * gr[2]; c[3] += w.w * gr[3];
        }
        const float mean = wave_sum(c[0] + c[1] + c[2] + c[3]) * (1.f / 256.f);
        float d2 = 0.f;
#pragma unroll
        for (int k = 0; k < 4; ++k) { c[k] -= mean; d2 += c[k] * c[k]; }
        const float rstd = rsqrtf(wave_sum(d2) * (1.f / 256.f) + EPS);
#pragma unroll
        for (int k = 0; k < 4; ++k) cln[t * 256 + lane * 4 + k] = silu_(c[k] * rstd * p->b_ln_g[l * 256 + lane * 4 + k] + p->b_ln_b[l * 256 + lane * 4 + k]);
    }
    __syncthreads();
    const int co = tid & 255, th = tid >> 8, half = nt >> 1, tb = th * half;
    float acc[16];
#pragma unroll
    for (int i = 0; i < 16; ++i) acc[i] = 0.f;
    const float* pw = p->b_pw_w + (size_t)l * 256 * 256 + co;
#pragma unroll 2
    for (int ci = 0; ci < 256; ++ci) {
        const float w = pw[(size_t)ci * 256];
#pragma unroll
        for (int i = 0; i < 16; ++i) if (i < half) acc[i] += cln[(tb + i) * 256 + ci] * w;
    }
    const float pb = p->b_pw_b[l * 256 + co];
#pragma unroll
    for (int i = 0; i < 16; ++i) if (i < half) {
        const size_t row = (size_t)(row0 + tb + i);
        const float z = bf2f(p->proj[row * PP + BZ + co]);
        p->mix[row * DM + 256 + co] = f2bf((acc[i] + pb) * silu_(z));
    }
    __syncthreads();
}

__device__ __forceinline__ void mixC_item(const PCP p, const int l, int item, float* lds) {
    const int tid = tid_();
    float* Ks = lds; float* Vs = lds + 256 * 65;
    const bool sample = item >= 256;
    const int kh = item & 1, b = item >> 7, qb = (item >> 1) & 63, n = (item - 256) >> 1;
    if (!sample) {
        for (int idx = tid; idx < 256 * 64; idx += 512) {
            const int j = idx >> 6, d = idx & 63, pos = (qb - 1) * 128 + j;
            float kv = 0.f, vv = 0.f;
            if (pos >= 0) { const size_t row = (size_t)b * SEQ + pos; kv = bf2f(p->proj[row * PP + CK + kh * 64 + d]); vv = bf2f(p->proj[row * PP + CV + kh * 64 + d]); }
            Ks[j * 65 + d] = kv; Vs[j * 65 + d] = vv;
            if (qb == 63 && j >= 128) { const size_t o = (((size_t)(l * 2 + b) * 128 + (j - 128)) * 2 + kh) * 64 + d; p->out[O_KP + o] = kv; p->out[O_VP + o] = vv; }
        }
    } else {
        for (int idx = tid; idx < 136 * 64; idx += 512) {
            const int j = idx >> 6, d = idx & 63;
            float kv, vv;
            if (j < 128) { const size_t o = ((((size_t)l * 128 + n) * 128 + j) * 2 + kh) * 64 + d; kv = p->cache_k[o]; vv = p->cache_v[o]; }
            else { const size_t row = (size_t)NP + n * 8 + (j - 128); kv = bf2f(p->proj[row * PP + CK + kh * 64 + d]); vv = bf2f(p->proj[row * PP + CV + kh * 64 + d]);
                   const size_t o = (((size_t)(l * 128 + n) * 8 + (j - 128)) * 2 + kh) * 64 + d; p->out[O_KS + o] = kv; p->out[O_VS + o] = vv; }
            Ks[j * 65 + d] = kv; Vs[j * 65 + d] = vv;
        }
    }
    __syncthreads();
    const int nq = sample ? 8 : 128;
    if (tid < 2 * nq) {
        const int qi = tid % nq, g = tid / nq, h = kh * 2 + g;
        const size_t row = sample ? (size_t)NP + n * 8 + qi : (size_t)b * SEQ + qb * 128 + qi;
        float qv[64], o[64];
#pragma unroll
        for (int d = 0; d < 64; ++d) { qv[d] = bf2f(p->proj[row * PP + CQ + h * 64 + d]) * 0.125f; o[d] = 0.f; }
        const float slope = exp2f(-2.f * (float)(h + 1));
        float m = p->c_sinks[l * 4 + h], lsum = 1.f;
        for (int j = qi; j <= qi + 128; ++j) {
            if (!sample && (qb - 1) * 128 + j < 0) continue;
            float s = 0.f;
#pragma unroll
            for (int d = 0; d < 64; ++d) s += qv[d] * Ks[j * 65 + d];
            s -= slope * (float)(qi + 128 - j);
            const float mn = fmaxf(m, s), sc = __expf(m - mn), pe = __expf(s - mn);
            lsum = lsum * sc + pe;
#pragma unroll
            for (int d = 0; d < 64; ++d) o[d] = o[d] * sc + pe * Vs[j * 65 + d];
            m = mn;
        }
        const float inv = 1.f / lsum;
#pragma unroll
        for (int d = 0; d < 64; ++d) {
            const float z = bf2f(p->proj[row * PP + CZ + h * 64 + d]);
            p->mix[row * DM + 512 + h * 64 + d] = f2bf(o[d] * inv * silu_(z));
        }
    }
    __syncthreads();
}

__device__ __forceinline__ void mixD_local_item(const PCP p, const int l, int item, unsigned char* ldsb) {
    const int tid = tid_();
    bf16* Xs = (bf16*)ldsb; bf16* Bs = Xs + 128 * 128; bf16* Cs = Bs + 128 * 128; bf16* Ss = Cs + 128 * 128;
    float* dts = (float*)(Ss + 128 * 128); float* acs = dts + 256; float* wts = acs + 256;
    const int cidx = item >> 1, g = item & 1, b = cidx >> 6, c = cidx & 63, t0 = c * 128; const size_t row0 = (size_t)b * SEQ + t0;
    for (int idx = tid; idx < 128 * 384; idx += 512) {
        const int t = idx / 384, cc = idx % 384, part = cc >> 7, col = cc & 127, xcol = part * 256 + g * 128 + col;
        float acc = p->d_conv_b[l * 768 + xcol];
#pragma unroll
        for (int j = 0; j < 4; ++j) { const int tt = t0 + t - 3 + j; if (tt >= 0) acc += p->d_conv_w[(l * 4 + j) * 768 + xcol] * bf2f(p->proj[((size_t)b * SEQ + tt) * PP + DX + xcol]); }
        const bf16 v = f2bf(silu_(acc));
        (part == 0 ? Xs : part == 1 ? Bs : Cs)[t * 128 + col] = v;
        if (c == 63 && t >= 125) p->out[O_CDP + ((size_t)(l * 2 + b) * 3 + (t - 125)) * 768 + xcol] = bf2f(p->proj[(row0 + t) * PP + DX + xcol]);
    }
    if (tid < 256) { const int h2 = tid >> 7, t = tid & 127, h = 2 * g + h2; dts[h2 * 128 + t] = softplus_(bf2f(p->proj[(row0 + t) * PP + DT + h]) + p->d_dt_bias[l * 4 + h]); }
    __syncthreads();
    if (tid < 2) { const int h = 2 * g + tid; const float a = -__expf(p->d_a_log[l * 4 + h]); float s = 0.f; for (int t = 0; t < 128; ++t) { s += dts[tid * 128 + t] * a; acs[tid * 128 + t] = s; } }
    __syncthreads();
    if (tid < 256) { const int h2 = tid >> 7, t = tid & 127, h = 2 * g + h2; p->acum[(row0 + t) * 4 + h] = acs[h2 * 128 + t]; }
    float gv[32];
    { const int t = tid >> 2;
#pragma unroll
      for (int i = 0; i < 32; ++i) { const int s = (tid & 3) + 4 * i; float acc = 0.f; if (s <= t) {
#pragma unroll 4
          for (int nn = 0; nn < 128; ++nn) acc += bf2f(Cs[t * 128 + nn]) * bf2f(Bs[s * 128 + nn]); } gv[i] = acc; } }
    for (int h2 = 0; h2 < 2; ++h2) {
        const int h = 2 * g + h2; const float aclast = acs[h2 * 128 + 127];
        { const int t = tid >> 2;
#pragma unroll
          for (int i = 0; i < 32; ++i) { const int s = (tid & 3) + 4 * i; Ss[t * 128 + s] = f2bf(s <= t ? gv[i] * __expf(acs[h2 * 128 + t] - acs[h2 * 128 + s]) * dts[h2 * 128 + s] : 0.f); } }
        if (tid < 128) wts[tid] = __expf(aclast - acs[h2 * 128 + tid]) * dts[h2 * 128 + tid];
        __syncthreads();
        { const int pcol = tid & 63, tq = tid >> 6; const float dsk = p->d_skip[l * 4 + h];
#pragma unroll 1
          for (int i = 0; i < 16; ++i) { const int t2 = tq + 8 * i; float acc = 0.f;
#pragma unroll 4
              for (int s = 0; s <= t2; ++s) acc += bf2f(Ss[t2 * 128 + s]) * bf2f(Xs[s * 128 + h2 * 64 + pcol]);
              acc += dsk * bf2f(Xs[t2 * 128 + h2 * 64 + pcol]);
              p->yd[(row0 + t2) * 256 + h * 64 + pcol] = acc; } }
        { const int nn = tid & 127, pq = tid >> 7;
#pragma unroll 1
          for (int i = 0; i < 16; ++i) { const int pp = pq + 4 * i; float acc = 0.f;
#pragma unroll 4
              for (int s = 0; s < 128; ++s) acc += wts[s] * bf2f(Xs[s * 128 + h2 * 64 + pp]) * bf2f(Bs[s * 128 + nn]);
              p->states[((size_t)(cidx * 4 + h) * 64 + pp) * 128 + nn] = acc; } }
        if (tid == 0) p->cdec[cidx * 4 + h] = __expf(aclast);
        __syncthreads();
    }
}
__device__ __forceinline__ void scan_phase(const PCP p, const int l) {
    for (int e = blockIdx.x * 512 + tid_(); e < NB * 4 * 64 * 128; e += gridDim.x * 512) {
        const int b = e >> 15, h = (e >> 13) & 3, pn = e & 8191;
        float hp = 0.f;
        for (int c = 0; c < 64; ++c) { const size_t o = ((size_t)((b * 64 + c) * 4 + h)) * 8192 + pn; const float st = p->states[o]; p->states[o] = hp; hp = hp * p->cdec[(b * 64 + c) * 4 + h] + st; }
        p->out[O_SSP + ((size_t)(l * 2 + b) * 4 + h) * 8192 + pn] = hp;
    }
}
__device__ __forceinline__ void mixD_finish_item(const PCP p, const int l, int item, unsigned char* ldsb) {
    const int tid = tid_(), lane = tid & 63, wave = tid >> 6;
    bf16* Cs = (bf16*)ldsb; float* Hin = (float*)(ldsb + 128 * 128 * 2);
    const int cidx = item >> 1, g = item & 1, b = cidx >> 6, c = cidx & 63, t0 = c * 128; const size_t row0 = (size_t)b * SEQ + t0;
    for (int idx = tid; idx < 128 * 128; idx += 512) {
        const int t = idx >> 7, col = idx & 127, xcol = 512 + g * 128 + col;
        float acc = p->d_conv_b[l * 768 + xcol];
#pragma unroll
        for (int j = 0; j < 4; ++j) { const int tt = t0 + t - 3 + j; if (tt >= 0) acc += p->d_conv_w[(l * 4 + j) * 768 + xcol] * bf2f(p->proj[((size_t)b * SEQ + tt) * PP + DX + xcol]); }
        Cs[t * 128 + col] = f2bf(silu_(acc));
    }
    for (int idx = tid; idx < 128 * 128; idx += 512) { const int hp = idx >> 7, nn = idx & 127; Hin[hp * 129 + nn] = p->states[((size_t)(cidx * 4 + 2 * g + (hp >> 6)) * 64 + (hp & 63)) * 128 + nn]; }
    __syncthreads();
    for (int t = wave; t < 128; t += 8) {
        float y[2]; float ss = 0.f;
#pragma unroll
        for (int k = 0; k < 2; ++k) {
            const int hp = lane + 64 * k, h = 2 * g + k;
            float acc = 0.f;
            for (int nn = 0; nn < 128; ++nn) acc += bf2f(Cs[t * 128 + nn]) * Hin[hp * 129 + nn];
            float v = p->yd[(row0 + t) * 256 + g * 128 + hp] + __expf(p->acum[(row0 + t) * 4 + h]) * acc;
            v *= silu_(bf2f(p->proj[(row0 + t) * PP + DZ + g * 128 + hp]));
            y[k] = v; ss += v * v;
        }
        const float rstd = rsqrtf(wave_sum(ss) * (1.f / 128.f) + EPS);
#pragma unroll
        for (int k = 0; k < 2; ++k) { const int hp = lane + 64 * k; p->mix[(row0 + t) * DM + 768 + g * 128 + hp] = f2bf(y[k] * rstd * p->d_norm_g[l * 256 + g * 128 + hp]); }
    }
    __syncthreads();
}
__device__ __forceinline__ void mixD_sample_item(const PCP p, const int l, int item, float* lds) {
    const int tid = tid_(), lane = tid & 63, wave = tid >> 6;
    float* X8 = lds; float* B8 = X8 + 8 * 128; float* C8 = B8 + 8 * 128; float* Y8 = C8 + 8 * 128; float* dt8 = Y8 + 8 * 128;
    const int n = item >> 1, g = item & 1; const size_t row0 = (size_t)NP + n * 8;
    for (int idx = tid; idx < 8 * 384; idx += 512) {
        const int t = idx / 384, cc = idx % 384, part = cc >> 7, col = cc & 127, xcol = part * 256 + g * 128 + col;
        float acc = p->d_conv_b[l * 768 + xcol];
#pragma unroll
        for (int j = 0; j < 4; ++j) { const int tt = t - 3 + j;
            const float xv = tt >= 0 ? bf2f(p->proj[(row0 + tt) * PP + DX + xcol]) : p->st_conv_d[((size_t)(l * 128 + n) * 3 + (tt + 3)) * 768 + xcol];
            acc += p->d_conv_w[(l * 4 + j) * 768 + xcol] * xv; }
        (part == 0 ? X8 : part == 1 ? B8 : C8)[t * 128 + col] = bf2f(f2bf(silu_(acc)));
        p->out[O_CDS + ((size_t)(l * 128 + n) * 8 + t) * 768 + xcol] = bf2f(p->proj[(row0 + t) * PP + DX + xcol]);
    }
    if (tid < 16) { const int h2 = tid >> 3, t = tid & 7, h = 2 * g + h2; dt8[h2 * 8 + t] = softplus_(bf2f(p->proj[(row0 + t) * PP + DT + h]) + p->d_dt_bias[l * 4 + h]); }
    __syncthreads();
    const int h2 = tid >> 8, pp = (tid >> 2) & 63, nr = (tid & 3) * 32, h = 2 * g + h2;
    const float a = -__expf(p->d_a_log[l * 4 + h]), dsk = p->d_skip[l * 4 + h];
    float hs[32];
    const size_t so = (((size_t)(l * 128 + n) * 4 + h) * 64 + pp) * 128 + nr;
#pragma unroll
    for (int k = 0; k < 32; k += 4) { const float4 v = *(const float4*)(p->st_ssm + so + k); hs[k] = v.x; hs[k + 1] = v.y; hs[k + 2] = v.z; hs[k + 3] = v.w; }
    for (int t = 0; t < 8; ++t) {
        const float dt = dt8[h2 * 8 + t], dA = __expf(dt * a), xv = X8[t * 128 + h2 * 64 + pp] * dt;
        float part = 0.f;
#pragma unroll
        for (int k = 0; k < 32; ++k) { hs[k] = hs[k] * dA + xv * B8[t * 128 + nr + k]; part += C8[t * 128 + nr + k] * hs[k]; }
        part += __shfl_xor(part, 1); part += __shfl_xor(part, 2);
        if ((tid & 3) == 0) Y8[t * 128 + h2 * 64 + pp] = part + dsk * X8[t * 128 + h2 * 64 + pp];
    }
#pragma unroll
    for (int k = 0; k < 32; k += 4) *(float4*)(p->out + O_SSS + so + k) = make_float4(hs[k], hs[k + 1], hs[k + 2], hs[k + 3]);
    __syncthreads();
    { const int t = wave; float y[2]; float ss = 0.f;
#pragma unroll
      for (int k = 0; k < 2; ++k) { const int hp = lane + 64 * k; float v = Y8[t * 128 + hp] * silu_(bf2f(p->proj[(row0 + t) * PP + DZ + g * 128 + hp])); y[k] = v; ss += v * v; }
      const float rstd = rsqrtf(wave_sum(ss) * (1.f / 128.f) + EPS);
#pragma unroll
      for (int k = 0; k < 2; ++k) { const int hp = lane + 64 * k; p->mix[(row0 + t) * DM + 768 + g * 128 + hp] = f2bf(y[k] * rstd * p->d_norm_g[l * 256 + g * 128 + hp]); } }
    __syncthreads();
}


__device__ __forceinline__ unsigned pk2(float lo, float hi) { return (unsigned)f2bf(lo) | ((unsigned)f2bf(hi) << 16); }
__device__ __forceinline__ void transpose_item(const float* W, int K, int N, bf16* WT, float* scr, int kb, int nb, int lane) {
    const int k0 = 64 * kb, n0 = 32 * nb;
#pragma unroll 8
    for (int i = 0; i < 32; ++i) { const int kk = 2 * i + (lane >> 5), n = n0 + (lane & 31); scr[kk * 33 + (lane & 31)] = n < N ? W[(size_t)(k0 + kk) * N + n] : 0.f; }
    asm volatile("s_waitcnt lgkmcnt(0)" ::: "memory");
    const int c = lane & 7;
#pragma unroll
    for (int j = 0; j < 4; ++j) { const int n = (lane >> 3) + 8 * j; const float* s = scr + (8 * c) * 33 + n;
        uint4 o; o.x = pk2(s[0 * 33], s[1 * 33]); o.y = pk2(s[2 * 33], s[3 * 33]); o.z = pk2(s[4 * 33], s[5 * 33]); o.w = pk2(s[6 * 33], s[7 * 33]);
        *(uint4*)(WT + (size_t)(n0 + n) * K + k0 + 8 * c) = o; }
    asm volatile("s_waitcnt lgkmcnt(0)" ::: "memory");
}

constexpr int LDS_BYTES = 147456;
#define GRID_SYNC() grid.sync()
__global__ void __launch_bounds__(512, 2) mega(P p_unused) {
    extern __shared__ __attribute__((aligned(16))) unsigned char lds[];
    cg::grid_group grid = cg::this_grid();
    const int tid = tid_(), lane = tid & 63, wave = tid >> 6, G = gridDim.x, bid = blockIdx.x;
    (void)tid;
    { const PCP p = getp(); float* scr = (float*)lds + wave * (64 * 33);
      constexpr int I_IN = (DM / 64) * (PP / 32), I_OUT = (DM / 64) * (DM / 32);
      for (int it = bid * 8 + wave; it < DEPTH * (I_IN + I_OUT); it += G * 8) {
          if (it < DEPTH * I_IN) { const int l = it / I_IN, r = it % I_IN; transpose_item(p->w_in + (size_t)l * DM * IN_DIM, DM, IN_DIM, p->win_t + (size_t)l * PP * DM, scr, r / (PP / 32), r % (PP / 32), lane); }
          else { const int q = it - DEPTH * I_IN, l = q / I_OUT, r = q % I_OUT; transpose_item(p->w_out + (size_t)l * DM * DM, DM, DM, p->wout_t + (size_t)l * DM * DM, scr, r / (DM / 32), r % (DM / 32), lane); }
      }
      norm0_phase(p); }
    GRID_SYNC();
#pragma unroll 1
    for (int l = 0; l < DEPTH; ++l) {
        { const PCP p = getp(); pg8::Gemm g; g.A = p->hb; g.Bt = p->win_t + (size_t)l * PP * DM; g.M = NTOK; g.N = PP; g.K = DM;
          pg8::EpiBf16<0> E; E.O = p->proj; E.ldc = PP; E.bias = nullptr; E.split_cols = 0; E.split_stride = 0; E.scale0 = 1.f;
          pg8::StaticOrder S; S.init(NTOK, PP, G, bid);
          pg8::gemm_phase<pg8::EpiBf16<0>, pg8::StaticOrder, true, true>((PG8_LAS unsigned char*)lds, g, S, E); }
        GRID_SYNC();
        for (int it = bid; it < 256; it += G) mixA_item(getp(), l, it, (float*)lds);
        for (int it = bid; it < 640; it += G) mixB_item(getp(), l, it, (float*)lds);
        for (int it = bid; it < 512; it += G) mixC_item(getp(), l, it, (float*)lds);
        for (int it = bid; it < 256; it += G) mixD_local_item(getp(), l, it, lds);
        for (int it = bid; it < 256; it += G) mixD_sample_item(getp(), l, it, (float*)lds);
        GRID_SYNC();
        scan_phase(getp(), l);
        GRID_SYNC();
        for (int it = bid; it < 256; it += G) mixD_finish_item(getp(), l, it, lds);
        GRID_SYNC();
        { const PCP p = getp(); pg8::Gemm g; g.A = p->mix; g.Bt = p->wout_t + (size_t)l * DM * DM; g.M = NTOK; g.N = DM; g.K = DM;
          pg8::EpiF32 E; E.C = p->mixed; E.ldc = DM; E.bias = nullptr;
          pg8::StaticOrder S; S.init(NTOK, DM, G, bid);
          pg8::gemm_phase<pg8::EpiF32, pg8::StaticOrder, true, true>((PG8_LAS unsigned char*)lds, g, S, E); }
        GRID_SYNC();
        post_phase(getp(), l);
        if (l + 1 < DEPTH) GRID_SYNC();
    }
}

extern "C" void kernel_launch(void* const* d_in, const int* in_sizes, int n_in, void* d_out, int out_size, void* d_ws, size_t ws_size, hipStream_t stream) {
    static int grid = 0;
    if (grid == 0) {
        if (n_in != 28 || in_sizes[0] != NP * DM || (size_t)out_size != O_END || ws_size < WS_END) {
            fprintf(stderr, "kernel_launch: unexpected shapes: n_in %d in0 %d out %d (want %zu) ws %zu (want >= %zu)\n", n_in, n_in > 0 ? in_sizes[0] : -1, out_size, (size_t)O_END, ws_size, (size_t)WS_END);
            grid = -1; return; }
        int dev = 0, cus = 0, per_cu = 0;
        if (hipGetDevice(&dev) != hipSuccess || hipDeviceGetAttribute(&cus, hipDeviceAttributeMultiprocessorCount, dev) != hipSuccess) { fprintf(stderr, "kernel_launch: device query failed\n"); grid = -1; return; }
        if (hipFuncSetAttribute((const void*)mega, hipFuncAttributeMaxDynamicSharedMemorySize, LDS_BYTES) != hipSuccess) { fprintf(stderr, "kernel_launch: hipFuncSetAttribute failed\n"); grid = -1; return; }
        if (hipOccupancyMaxActiveBlocksPerMultiprocessor(&per_cu, (const void*)mega, 512, LDS_BYTES) != hipSuccess || per_cu < 1) { fprintf(stderr, "kernel_launch: occupancy query says %d blocks/CU\n", per_cu); grid = -1; return; }
        (void)hipGetLastError();
        grid = cus;
    }
    if (grid < 0) return;
    unsigned char* ws = (unsigned char*)d_ws;
    P p; memset(&p, 0, sizeof p);
    const float** f = (const float**)&p;
    for (int i = 0; i < 28; ++i) f[i] = (const float*)d_in[i];
    p.out = (float*)d_out;
    p.win_t = (bf16*)(ws + WS_WIN); p.wout_t = (bf16*)(ws + WS_WOUT); p.hb = (bf16*)(ws + WS_HB); p.mix = (bf16*)(ws + WS_MIX); p.proj = (bf16*)(ws + WS_PROJ);
    p.mixed = (float*)(ws + WS_MIXED); p.yd = (float*)(ws + WS_YD); p.states = (float*)(ws + WS_ST); p.acum = (float*)(ws + WS_AC); p.cdec = (float*)(ws + WS_CD);
    void* args[] = {&p};
    const hipError_t e = hipLaunchCooperativeKernel((const void*)mega, dim3(grid), dim3(512), args, LDS_BYTES, stream);
    if (e != hipSuccess) fprintf(stderr, "kernel_launch: cooperative launch failed: %s (grid %d)\n", hipGetErrorString(e), grid);
}
```

```cpp
#include <hip/hip_runtime.h>
#include <cstdio>
#include <cstdint>
#include <cstring>
#include <hip/hip_cooperative_groups.h>
namespace cg = cooperative_groups;
namespace pg8 {
#define PG8_LAS __attribute__((address_space(3)))
typedef unsigned short bf16_t;
typedef short bf16x8 __attribute__((ext_vector_type(8)));
typedef float f32x4 __attribute__((ext_vector_type(4)));
typedef unsigned u32x4 __attribute__((ext_vector_type(4)));
constexpr int BM = 256, BK = 64, HALF = 128, HTB = HALF * BK * 2  , STAGE_BYTES = 8 * HTB, NXCD = 8, WGM = 8;

__host__ __device__ __forceinline__ int lds_byte(int r, int c) { const int st = (r >> 4) * 2 + (c >> 5), rr = r & 15, cc = c & 31, ob = rr * 64 + cc * 2; return st * 1024 + (ob ^ (((ob >> 9) & 1) << 5)); }
__host__ __device__ __forceinline__ void stage_rc(int b, int& R, int& C) { const int st = b / 1024, sb = b % 1024, swz = sb ^ (((sb >> 9) & 1) << 5); R = (st >> 1) * 16 + swz / 64; C = (st & 1) * 32 + (swz % 64) / 2; }
__host__ __device__ __forceinline__ int perm32(int rho) { const int n = rho >> 4, i = rho & 15; return 8 * (i >> 2) + 4 * n + (i & 3); }

struct Unit { int pm, pn; };
struct Gemm { const bf16_t* A; const bf16_t* Bt; int M, N, K; };

struct StaticOrder {
    int nM, nN, nwg, G, c;
    __host__ __device__ void init(int M, int N, int G_, int c_) { nM = M / BM; nN = N / BM; nwg = nM * nN; G = G_; c = c_; }
    __host__ __device__ bool next(int i, Unit& u) const {
        const long L = (long)i * G + c; if (L >= nwg) return false;
        int wgid = (int)L; { const int q = nwg / NXCD, r = nwg % NXCD, xcd = wgid % NXCD, off = wgid / NXCD; wgid = (xcd < r ? xcd * (q + 1) : r * (q + 1) + (xcd - r) * q) + off; }
        const int nig = WGM * nN, gid = wgid / nig, fm = gid * WGM, gsz = (nM - fm) < WGM ? (nM - fm) : WGM;
        u.pm = fm + ((wgid % nig) % gsz); u.pn = (wgid % nig) / gsz; return true;
    }
    __device__ __forceinline__ void a_ready(const Unit&) const {}
    __device__ __forceinline__ void done(const Unit&) const {}
};

__device__ __forceinline__ unsigned cvt_pk_bf16(float lo, float hi) { unsigned r; asm volatile("v_cvt_pk_bf16_f32 %0, %1, %2" : "=v"(r) : "v"(lo), "v"(hi)); return r; }
typedef float f32x2 __attribute__((ext_vector_type(2)));
__device__ __forceinline__ f32x2 gelu_pk(f32x2 v) {
    const f32x2 av = __builtin_elementwise_abs(v), d = av * 0.2316418882f + 1.0f;
    f32x2 t; t.x = __builtin_amdgcn_rcpf(d.x); t.y = __builtin_amdgcn_rcpf(d.y);
    f32x2 q = t * 0.5307027145f + (-0.7265760135f); q = q * t + 0.7107068705f; q = q * t + (-0.142248368f); q = q * t + 0.127414796f; q = q * t;
    const f32x2 s = (v * v) * (-0.72134752044f);
    f32x2 e; e.x = __builtin_amdgcn_exp2f(s.x); e.y = __builtin_amdgcn_exp2f(s.y);
    const f32x2 m = v * (q * e), r = v - m;
    f32x2 o; o.x = v.x < 0.f ? m.x : r.x; o.y = v.y < 0.f ? m.y : r.y; return o;
}

struct EpiF32 {
    static constexpr bool PERM = false, AFTER_DRAIN = false;
    float* C; int ldc; const float* bias;
    __device__ __forceinline__ void operator()(const f32x4 (&acc)[2][2][4][2], const Unit& u, int wr, int wc, int fr, int fq) const {
        const int row0 = u.pm * BM + wr * 64 + fr, col0 = u.pn * BM + wc * 32 + 4 * fq;
        f32x4 bv[2][2];
#pragma unroll
        for (int bj = 0; bj < 2; ++bj)
#pragma unroll
            for (int n = 0; n < 2; ++n) bv[bj][n] = bias ? *(const f32x4*)(bias + col0 + bj * HALF + n * 16) : (f32x4){0.f, 0.f, 0.f, 0.f};
#pragma unroll
        for (int ai = 0; ai < 2; ++ai)
#pragma unroll
            for (int m = 0; m < 4; ++m) { float* rowp = C + (size_t)(row0 + ai * HALF + m * 16) * ldc + col0;
#pragma unroll
                for (int bj = 0; bj < 2; ++bj)
#pragma unroll
                    for (int n = 0; n < 2; ++n) *(f32x4*)(rowp + bj * HALF + n * 16) = acc[ai][bj][m][n] + bv[bj][n]; }
    }
};
template <int ACT  > struct EpiBf16 {
    static constexpr bool PERM = true, AFTER_DRAIN = false; static_assert(ACT == 0 || ACT == 1, "EpiBf16: ACT is 0 (none) or 1 (gelu_pk)");
    bf16_t* O; int ldc; const float* bias; int split_cols; size_t split_stride; float scale0;
    __device__ __forceinline__ void operator()(const f32x4 (&acc)[2][2][4][2], const Unit& u, int wr, int wc, int fr, int fq) const {
        const int row0 = u.pm * BM + wr * 64 + fr; int colt = u.pn * BM; bf16_t* base = O;
        float sc = 1.f; if (split_cols) { const int t = colt / split_cols; base += (size_t)t * split_stride; colt -= t * split_cols; if (t == 0) sc = scale0; }
        const int col0 = colt + wc * 32 + 8 * fq, bcol0 = u.pn * BM + wc * 32 + 8 * fq;
        f32x4 bv[2][2];
#pragma unroll
        for (int bj = 0; bj < 2; ++bj)
#pragma unroll
            for (int n = 0; n < 2; ++n) bv[bj][n] = bias ? *(const f32x4*)(bias + bcol0 + bj * HALF + 4 * n) : (f32x4){0.f, 0.f, 0.f, 0.f};
#pragma unroll
        for (int ai = 0; ai < 2; ++ai)
#pragma unroll
            for (int m = 0; m < 4; ++m) { bf16_t* rowp = base + (size_t)(row0 + ai * HALF + m * 16) * ldc + col0;
#pragma unroll
                for (int bj = 0; bj < 2; ++bj) { f32x4 v0 = acc[ai][bj][m][0] + bv[bj][0], v1 = acc[ai][bj][m][1] + bv[bj][1];
                    if (ACT == 1) { f32x2 a = gelu_pk((f32x2){v0[0], v0[1]}), b = gelu_pk((f32x2){v0[2], v0[3]}), c = gelu_pk((f32x2){v1[0], v1[1]}), d = gelu_pk((f32x2){v1[2], v1[3]});
                        v0 = (f32x4){a.x, a.y, b.x, b.y}; v1 = (f32x4){c.x, c.y, d.x, d.y}; }
                    v0 = v0 * sc; v1 = v1 * sc; u32x4 w; w.x = cvt_pk_bf16(v0[0], v0[1]); w.y = cvt_pk_bf16(v0[2], v0[3]); w.z = cvt_pk_bf16(v1[0], v1[1]); w.w = cvt_pk_bf16(v1[2], v1[3]);
                    *(u32x4*)(rowp + bj * HALF) = w; } }
    }
};

struct PanelStats {
    unsigned* xbuf;
    unsigned* cnt;
    unsigned* tmo;
    int ntn; float eps;
    unsigned code;
    __device__ __forceinline__ bool run(const f32x4 (&v)[2][2][4][2], const Unit& u, int wr, int wc, int fr, int fq, PG8_LAS unsigned char* lds, int wid, int lane) const {
        typedef float f32x2v __attribute__((ext_vector_type(2)));
        PG8_LAS f32x2v* P = (PG8_LAS f32x2v*)lds;
        PG8_LAS f32x2v* S = (PG8_LAS f32x2v*)(lds + 8192);
        PG8_LAS unsigned* flag = (PG8_LAS unsigned*)(lds + 8192 + 2048);
#pragma unroll
        for (int ai = 0; ai < 2; ++ai)
#pragma unroll
            for (int m = 0; m < 4; ++m) {
                float s = 0.f;
#pragma unroll
                for (int bj = 0; bj < 2; ++bj)
#pragma unroll
                    for (int n = 0; n < 2; ++n) { const f32x4 x = v[ai][bj][m][n]; s += (x[0] + x[1]) + (x[2] + x[3]); }
                s += __shfl_xor(s, 16); s += __shfl_xor(s, 32);
                const float mw = s * (1.0f / 64.0f); float q = 0.f;
#pragma unroll
                for (int bj = 0; bj < 2; ++bj)
#pragma unroll
                    for (int n = 0; n < 2; ++n) { const f32x4 d = v[ai][bj][m][n] - mw; q += (d[0] * d[0] + d[1] * d[1]) + (d[2] * d[2] + d[3] * d[3]); }
                q += __shfl_xor(q, 16); q += __shfl_xor(q, 32);
                if (fq == 0) P[(ai * HALF + wr * 64 + m * 16 + fr) * 4 + wc] = (f32x2v){mw, q};
            }
        asm volatile("s_waitcnt lgkmcnt(0)" ::: "memory"); __builtin_amdgcn_s_barrier(); asm volatile("" ::: "memory");
#if defined(BROKEN_EXCHANGE_NO_WAIT)
#warning BROKEN CONTROL BUILD: the row-statistics exchange does not wait; results are wrong by design
        if (blockIdx.x >= 64) { const long long t0_ = clock64(); while (clock64() - t0_ < 60000) __builtin_amdgcn_s_sleep(8); }
#endif
        const int row = wid * 32 + (lane & 31);
        if (lane < 32) {
            const f32x2v a = P[row * 4 + 0], b = P[row * 4 + 1], c = P[row * 4 + 2], d = P[row * 4 + 3];
            const float mt = (a.x + b.x + c.x + d.x) * 0.25f;
            const float da = a.x - mt, db = b.x - mt, dc = c.x - mt, dd = d.x - mt;
            const float m2 = (a.y + b.y) + (c.y + d.y) + 64.0f * ((da * da + db * db) + (dc * dc + dd * dd));
            unsigned long long* slot = (unsigned long long*)xbuf + ((size_t)(u.pm * BM + row) * 4 + u.pn);
            __hip_atomic_store(slot, ((unsigned long long)__float_as_uint(m2) << 32) | __float_as_uint(mt), __ATOMIC_RELAXED, __HIP_MEMORY_SCOPE_AGENT);
        }
        asm volatile("s_waitcnt vmcnt(0)" ::: "memory");
        if (lane == 0) __hip_atomic_fetch_add(cnt + 64 * u.pm, 1u, __ATOMIC_RELAXED, __HIP_MEMORY_SCOPE_AGENT);
        if (wid == 0) {
            bool dead = false; const unsigned long long t0 = __builtin_amdgcn_s_memrealtime(); const unsigned want = 8u * (unsigned)ntn;
            for (;;) {
#if defined(BROKEN_EXCHANGE_NO_WAIT)
                break;
#endif
                if ((unsigned)__builtin_amdgcn_readfirstlane(__hip_atomic_load(cnt + 64 * u.pm, __ATOMIC_RELAXED, __HIP_MEMORY_SCOPE_AGENT)) >= want) break;
                if (__builtin_amdgcn_s_memrealtime() - t0 > 2000000ull) {
                    if (lane == 0) { unsigned expect = 0u; __hip_atomic_compare_exchange_strong(tmo + 1, &expect, code | (unsigned)(u.pm & 0xff), __ATOMIC_RELAXED, __ATOMIC_RELAXED, __HIP_MEMORY_SCOPE_AGENT);
                                     __hip_atomic_store(tmo, 1u, __ATOMIC_RELAXED, __HIP_MEMORY_SCOPE_AGENT); }
                    dead = true; break; }
                __builtin_amdgcn_s_sleep(2);
            }
            __builtin_amdgcn_fence(__ATOMIC_ACQUIRE, "agent");
            if (lane == 0) flag[0] = dead ? 1u : 0u;
        }
        asm volatile("s_waitcnt vmcnt(0) lgkmcnt(0)" ::: "memory"); __builtin_amdgcn_s_barrier(); asm volatile("" ::: "memory");
        const bool bad = flag[0] != 0u;
        if (lane < 32) {
            const unsigned long long* slot = (const unsigned long long*)xbuf + (size_t)(u.pm * BM + row) * 4; float mt[4], m2[4]; float ms = 0.f;
#pragma unroll
            for (int t = 0; t < 4; ++t) { if (t < ntn) { const unsigned long long w = __hip_atomic_load(slot + t, __ATOMIC_RELAXED, __HIP_MEMORY_SCOPE_AGENT); mt[t] = __uint_as_float((unsigned)w); m2[t] = __uint_as_float((unsigned)(w >> 32)); } else { mt[t] = 0.f; m2[t] = 0.f; } ms += mt[t]; }
            const float mean = ms / (float)ntn; float q = 0.f;
#pragma unroll
            for (int t = 0; t < 4; ++t) if (t < ntn) { const float dm = mt[t] - mean; q += m2[t] + 256.0f * dm * dm; }
            S[row] = (f32x2v){mean, 1.0f / sqrtf(q / (256.0f * (float)ntn) + eps)};
        }
        asm volatile("s_waitcnt lgkmcnt(0)" ::: "memory"); __builtin_amdgcn_s_barrier(); asm volatile("" ::: "memory");
        return bad;
    }
};
struct EpiLnRes {
    static constexpr bool PERM = false, AFTER_DRAIN = true;
    const float* base; float* out; int ldc; const float* bias; PanelStats st; unsigned poison;
    __device__ __forceinline__ void fused(f32x4 (&acc)[2][2][4][2], const Unit& u, int wr, int wc, int fr, int fq, PG8_LAS unsigned char* lds, int wid, int lane) const {
        typedef float f32x2v __attribute__((ext_vector_type(2)));
        const PG8_LAS f32x2v* S = (const PG8_LAS f32x2v*)(lds + 8192);
        const int col0 = u.pn * BM + wc * 32 + 4 * fq;
#pragma unroll
        for (int bj = 0; bj < 2; ++bj)
#pragma unroll
            for (int n = 0; n < 2; ++n) { const f32x4 bv = bias ? *(const f32x4*)(bias + col0 + bj * HALF + n * 16) : (f32x4){0.f, 0.f, 0.f, 0.f};
#pragma unroll
                for (int ai = 0; ai < 2; ++ai)
#pragma unroll
                    for (int m = 0; m < 4; ++m) acc[ai][bj][m][n] += bv; }
        f32x4 pre[4][2][2];
#pragma unroll
        for (int m = 0; m < 4; ++m) { const size_t off = (size_t)(u.pm * BM + wr * 64 + m * 16 + fr) * ldc + col0;
#pragma unroll
            for (int bj = 0; bj < 2; ++bj)
#pragma unroll
                for (int n = 0; n < 2; ++n) pre[m][bj][n] = *(const f32x4*)(base + off + bj * HALF + n * 16); }
        const bool bad = st.run(acc, u, wr, wc, fr, fq, lds, wid, lane) || poison != 0u;
        const float qnan = __builtin_nanf("");
#pragma unroll
        for (int ai = 0; ai < 2; ++ai)
#pragma unroll
            for (int m = 0; m < 4; ++m) { const int r = ai * HALF + wr * 64 + m * 16 + fr; const f32x2v sr = S[r]; const size_t off = (size_t)(u.pm * BM + r) * ldc + col0;
#pragma unroll
                for (int bj = 0; bj < 2; ++bj)
#pragma unroll
                    for (int n = 0; n < 2; ++n) { const f32x4 bs = ai == 0 ? pre[m][bj][n] : *(const f32x4*)(base + off + bj * HALF + n * 16); f32x4 o = bs + (acc[ai][bj][m][n] - sr.x) * sr.y;
                        if (bad) o = (f32x4){qnan, qnan, qnan, qnan}; *(f32x4*)(out + off + bj * HALF + n * 16) = o; }
                if (m & 1) asm volatile("" ::: "memory"); }
    }
};
struct EpiLnResLn {
    static constexpr bool PERM = false, AFTER_DRAIN = true;
    const float* base; float* out; bf16_t* xn; int ldc; const float* bias; PanelStats st1, st2; unsigned poison;
    __device__ __forceinline__ void fused(f32x4 (&acc)[2][2][4][2], const Unit& u, int wr, int wc, int fr, int fq, PG8_LAS unsigned char* lds, int wid, int lane) const {
        typedef float f32x2v __attribute__((ext_vector_type(2))); typedef unsigned u32x2v __attribute__((ext_vector_type(2)));
        const PG8_LAS f32x2v* S = (const PG8_LAS f32x2v*)(lds + 8192);
        const int col0 = u.pn * BM + wc * 32 + 4 * fq;
#pragma unroll
        for (int bj = 0; bj < 2; ++bj)
#pragma unroll
            for (int n = 0; n < 2; ++n) { const f32x4 bv = bias ? *(const f32x4*)(bias + col0 + bj * HALF + n * 16) : (f32x4){0.f, 0.f, 0.f, 0.f};
#pragma unroll
                for (int ai = 0; ai < 2; ++ai)
#pragma unroll
                    for (int m = 0; m < 4; ++m) acc[ai][bj][m][n] += bv; }
        bool bad = st1.run(acc, u, wr, wc, fr, fq, lds, wid, lane) || poison != 0u;
        const float qnan = __builtin_nanf("");
#pragma unroll
        for (int ai = 0; ai < 2; ++ai)
#pragma unroll
            for (int m = 0; m < 4; ++m) { const int r = ai * HALF + wr * 64 + m * 16 + fr; const f32x2v sr = S[r]; const size_t off = (size_t)(u.pm * BM + r) * ldc + col0;
#pragma unroll
                for (int bj = 0; bj < 2; ++bj)
#pragma unroll
                    for (int n = 0; n < 2; ++n) { const f32x4 bs = *(const f32x4*)(base + off + bj * HALF + n * 16); acc[ai][bj][m][n] = bs + (acc[ai][bj][m][n] - sr.x) * sr.y; }
                asm volatile("" : "+v"(acc[ai][0][m][0]), "+v"(acc[ai][0][m][1]), "+v"(acc[ai][1][m][0]), "+v"(acc[ai][1][m][1]));
                if (m & 1) asm volatile("" ::: "memory"); }
        const bool bad1 = bad;
        bad = st2.run(acc, u, wr, wc, fr, fq, lds, wid, lane) || bad;
#pragma unroll
        for (int ai = 0; ai < 2; ++ai)
#pragma unroll
            for (int m = 0; m < 4; ++m) { const int r = ai * HALF + wr * 64 + m * 16 + fr; const f32x2v sr = S[r]; const size_t off = (size_t)(u.pm * BM + r) * ldc + col0;
#pragma unroll
                for (int bj = 0; bj < 2; ++bj)
#pragma unroll
                    for (int n = 0; n < 2; ++n) { const f32x4 x1 = acc[ai][bj][m][n]; *(f32x4*)(out + off + bj * HALF + n * 16) = bad1 ? (f32x4){qnan, qnan, qnan, qnan} : x1;
                        const f32x4 o = (x1 - sr.x) * sr.y; u32x2v w; w.x = cvt_pk_bf16(o[0], o[1]); w.y = cvt_pk_bf16(o[2], o[3]);
                        if (bad) { w.x = 0x7fc07fc0u; w.y = 0x7fc07fc0u; } *(u32x2v*)(xn + off + bj * HALF + n * 16) = w; }
                asm volatile("" ::: "memory"); }
    }
};

template <class Epi, class Sched, bool ALIGN_EPI = false, bool SP2 = false>
__device__ __forceinline__ void gemm_phase(PG8_LAS unsigned char* lds, const Gemm g, const Sched& S, const Epi& E) {
    const int tid = threadIdx.x, wid = __builtin_amdgcn_readfirstlane(tid >> 6), lane = tid & 63, wr = wid >> 2, wc = wid & 3, fr = lane & 15, fq = lane >> 4;
    const int K = g.K, nt = K / BK;
    unsigned voffA[2], voffB[2];
#pragma unroll
    for (int i = 0; i < 2; ++i) { int R, C; stage_rc(tid * 16 + i * 8192, R, C); const int Rb = Epi::PERM ? ((R & ~31) + perm32(R & 31)) : R;
        voffA[i] = (unsigned)(R * K + C) * 2u; voffB[i] = (unsigned)(Rb * K + C) * 2u; }
    const size_t kstep = (size_t)(BK * 2);
    const size_t hstep = (size_t)HALF * K * 2;
    const size_t tstep = 2 * hstep;
    const unsigned ldsw = (unsigned)wid * 1024u;
    const int aoff = lds_byte(wr * 64 + fr, fq * 8), boff = lds_byte(wc * 32 + fr, fq * 8);
#define PG8_SA(b, h) (((b) * 2 + (h)) * HTB)
#define PG8_SB(b, h) ((4 + (b) * 2 + (h)) * HTB)
#define PG8_STAGE(bufoff, gbase, voff) do { _Pragma("unroll") for (int _i = 0; _i < 2; ++_i) \
        __builtin_amdgcn_global_load_lds((const unsigned*)((const char*)(gbase) + (voff)[_i]), (PG8_LAS unsigned*)(lds + (bufoff) + ldsw + _i * 8192), 16, 0, 0); } while (0)
#define PG8_LDA(dst, b, h) do { _Pragma("unroll") for (int m = 0; m < 4; ++m) _Pragma("unroll") for (int k = 0; k < 2; ++k) dst[m][k] = *(const PG8_LAS bf16x8*)(lds + PG8_SA(b, h) + aoff + m * 2048 + k * 1024); } while (0)
#define PG8_LDB(dst, b, h) do { _Pragma("unroll") for (int n = 0; n < 2; ++n) _Pragma("unroll") for (int k = 0; k < 2; ++k) dst[n][k] = *(const PG8_LAS bf16x8*)(lds + PG8_SB(b, h) + boff + n * 2048 + k * 1024); } while (0)
#define PG8_MMA(ai, bj, At, Bt) do { __builtin_amdgcn_s_setprio(1); _Pragma("unroll") for (int m = 0; m < 4; ++m) _Pragma("unroll") for (int n = 0; n < 2; ++n) _Pragma("unroll") for (int k = 0; k < 2; ++k) \
        acc[ai][bj][m][n] = __builtin_amdgcn_mfma_f32_16x16x32_bf16(Bt[n][k], At[m][k], acc[ai][bj][m][n], 0, 0, 0); __builtin_amdgcn_s_setprio(0); } while (0)
#define PG8_WAIT_V(n) asm volatile("s_waitcnt vmcnt(" #n ")" ::: "memory")
#define PG8_WAIT_L(n) asm volatile("s_waitcnt lgkmcnt(" #n ")" ::: "memory")
#define PG8_BAR __builtin_amdgcn_s_barrier()
#define PG8_SCHED __builtin_amdgcn_sched_barrier(0)
    Unit cur, nxt; int ui = 0;
    if (!S.next(0, cur)) return;
    f32x4 acc[2][2][4][2];
#pragma unroll
    for (int a = 0; a < 2; ++a)
#pragma unroll
        for (int b = 0; b < 2; ++b)
#pragma unroll
            for (int m = 0; m < 4; ++m)
#pragma unroll
                for (int n = 0; n < 2; ++n) acc[a][b][m][n] = (f32x4){0.f, 0.f, 0.f, 0.f};
    bf16x8 At[4][2], B0[2][2], B1[2][2];
    const char* cA = (const char*)g.A + (size_t)cur.pm * tstep; const char* cB = (const char*)g.Bt + (size_t)cur.pn * tstep;
    S.a_ready(cur);
    if constexpr (SP2) {
        PG8_STAGE(PG8_SB(0, 0), cB, voffB); PG8_STAGE(PG8_SB(0, 1), cB + hstep, voffB); PG8_STAGE(PG8_SA(0, 0), cA, voffA); PG8_STAGE(PG8_SA(0, 1), cA + hstep, voffA);
        if (wr == 1) PG8_BAR;
        PG8_WAIT_V(2); PG8_BAR;
        PG8_STAGE(PG8_SB(1, 0), cB + kstep, voffB); PG8_STAGE(PG8_SA(1, 0), cA + kstep, voffA); PG8_STAGE(PG8_SB(1, 1), cB + hstep + kstep, voffB);
        PG8_WAIT_V(6); PG8_BAR;
    } else {
        PG8_STAGE(PG8_SB(0, 0), cB, voffB); PG8_STAGE(PG8_SA(0, 0), cA, voffA); PG8_STAGE(PG8_SB(0, 1), cB + hstep, voffB); PG8_STAGE(PG8_SA(0, 1), cA + hstep, voffA);
        if (wr == 1) PG8_BAR;
        PG8_WAIT_V(4); PG8_BAR;
        PG8_STAGE(PG8_SB(1, 0), cB + kstep, voffB); PG8_STAGE(PG8_SA(1, 0), cA + kstep, voffA); PG8_STAGE(PG8_SB(1, 1), cB + hstep + kstep, voffB);
        PG8_WAIT_V(6); PG8_BAR;
    }
    for (;;) {
        const bool has_next = S.next(ui + 1, nxt);
        const char* nA = has_next ? (const char*)g.A + (size_t)nxt.pm * tstep : cA; const char* nB = has_next ? (const char*)g.Bt + (size_t)nxt.pn * tstep : cB;
        for (int t = 0; t < nt; t += 2) {
            const bool last = (t == nt - 2);
            const char* a1 = cA + (size_t)(t + 1) * kstep;
            const char* a2 = last ? nA : cA + (size_t)(t + 2) * kstep; const char* b2 = last ? nB : cB + (size_t)(t + 2) * kstep;
            const char* a3 = a2 + kstep; const char* b3 = b2 + kstep;
            if (last && has_next) S.a_ready(nxt);
            if constexpr (SP2) {
            PG8_LDB(B0, 0, 0); PG8_LDB(B1, 0, 1); PG8_SCHED; PG8_LDA(At, 0, 0); PG8_STAGE(PG8_SA(1, 1), a1 + hstep, voffA);
            PG8_WAIT_V(8); PG8_WAIT_L(0); PG8_BAR; PG8_MMA(0, 0, At, B0); PG8_MMA(0, 1, At, B1); PG8_BAR; PG8_SCHED;
            PG8_LDA(At, 0, 1); PG8_STAGE(PG8_SB(0, 0), b2, voffB); PG8_STAGE(PG8_SB(0, 1), b2 + hstep, voffB); PG8_STAGE(PG8_SA(0, 0), a2, voffA);
            PG8_WAIT_V(8); PG8_WAIT_L(0); PG8_BAR; PG8_MMA(1, 0, At, B0); PG8_MMA(1, 1, At, B1); PG8_BAR; PG8_SCHED;
            PG8_LDB(B0, 1, 0); PG8_LDB(B1, 1, 1); PG8_SCHED; PG8_LDA(At, 1, 0); PG8_STAGE(PG8_SA(0, 1), a2 + hstep, voffA);
            PG8_WAIT_V(8); PG8_WAIT_L(0); PG8_BAR; PG8_MMA(0, 0, At, B0); PG8_MMA(0, 1, At, B1); PG8_BAR; PG8_SCHED;
            PG8_LDA(At, 1, 1); PG8_STAGE(PG8_SB(1, 0), b3, voffB); PG8_STAGE(PG8_SB(1, 1), b3 + hstep, voffB); PG8_STAGE(PG8_SA(1, 0), a3, voffA);
            PG8_WAIT_V(8); PG8_WAIT_L(0); PG8_BAR; PG8_MMA(1, 0, At, B0); PG8_MMA(1, 1, At, B1); PG8_BAR; PG8_SCHED;
            } else {
            PG8_LDB(B0, 0, 0); PG8_SCHED; PG8_LDA(At, 0, 0); PG8_STAGE(PG8_SA(1, 1), a1 + hstep, voffA);
            PG8_WAIT_L(8); PG8_BAR; PG8_WAIT_L(0); PG8_MMA(0, 0, At, B0); PG8_BAR; PG8_SCHED;
            PG8_LDB(B1, 0, 1); PG8_STAGE(PG8_SB(0, 0), b2, voffB);
            PG8_BAR; PG8_WAIT_L(0); PG8_MMA(0, 1, At, B1); PG8_BAR;
            PG8_LDA(At, 0, 1); PG8_STAGE(PG8_SA(0, 0), a2, voffA);
            PG8_BAR; PG8_WAIT_L(0); PG8_MMA(1, 0, At, B0); PG8_BAR; PG8_SCHED;
            PG8_STAGE(PG8_SB(0, 1), b2 + hstep, voffB);
            PG8_WAIT_V(6); PG8_BAR; PG8_MMA(1, 1, At, B1); PG8_BAR;
            PG8_LDB(B0, 1, 0); PG8_SCHED; PG8_LDA(At, 1, 0); PG8_STAGE(PG8_SA(0, 1), a2 + hstep, voffA);
            PG8_WAIT_L(8); PG8_BAR; PG8_WAIT_L(0); PG8_MMA(0, 0, At, B0); PG8_BAR; PG8_SCHED;
            PG8_LDB(B1, 1, 1); PG8_STAGE(PG8_SB(1, 0), b3, voffB);
            PG8_BAR; PG8_WAIT_L(0); PG8_MMA(0, 1, At, B1); PG8_BAR;
            PG8_LDA(At, 1, 1); PG8_STAGE(PG8_SA(1, 0), a3, voffA);
            PG8_BAR; PG8_WAIT_L(0); PG8_MMA(1, 0, At, B0); PG8_BAR; PG8_SCHED;
            PG8_STAGE(PG8_SB(1, 1), b3 + hstep, voffB);
            PG8_WAIT_V(6); PG8_BAR; PG8_MMA(1, 1, At, B1); PG8_BAR;
            }
        }
        if constexpr (ALIGN_EPI) { if (wr == 0) PG8_BAR; }
        if constexpr (!Epi::AFTER_DRAIN) { E(acc, cur, wr, wc, fr, fq); S.done(cur); }
        if (!has_next) break;
#pragma unroll
        for (int a = 0; a < 2; ++a)
#pragma unroll
            for (int b = 0; b < 2; ++b)
#pragma unroll
                for (int m = 0; m < 4; ++m)
#pragma unroll
                    for (int n = 0; n < 2; ++n) acc[a][b][m][n] = (f32x4){0.f, 0.f, 0.f, 0.f};
        cur = nxt; cA = nA; cB = nB; ++ui;
        if constexpr (ALIGN_EPI) { if (wr == 1) PG8_BAR; }
    }
    PG8_WAIT_V(0);
    if constexpr (!ALIGN_EPI) { if (wr == 0) PG8_BAR; }
    PG8_BAR;
    if constexpr (Epi::AFTER_DRAIN) { E.fused(acc, cur, wr, wc, fr, fq, lds, wid, lane); S.done(cur); }
#undef PG8_SA
#undef PG8_SB
#undef PG8_STAGE
#undef PG8_LDA
#undef PG8_LDB
#undef PG8_MMA
#undef PG8_WAIT_V
#undef PG8_WAIT_L
#undef PG8_BAR
#undef PG8_SCHED
}
}

typedef unsigned short bf16;
constexpr int DM = 1024, SEQ = 8192, NB = 2, DEPTH = 4, SB = 128, SL = 8;
constexpr int NP = NB * SEQ;
constexpr int NS = SB * SL;
constexpr int NTOK = NP + NS;
constexpr int IN_DIM = 3332, PP = 3584;
constexpr int AU = 0, AV = 256, AZ = 512, BV = 768, BG = 1024, BZ = 1280, CQ = 1536, CK = 1792, CV = 1920, CZ = 2048, DZ = 2304, DX = 2560, DT = 3328;
constexpr float EPS = 1e-6f;
constexpr size_t O_YP = 0, O_YS = O_YP + (size_t)NP * DM, O_KP = O_YS + (size_t)NS * DM, O_KS = O_KP + 4 * 2 * 128 * 128, O_VP = O_KS + 4 * 128 * 8 * 128,
                 O_VS = O_VP + 4 * 2 * 128 * 128, O_CBP = O_VS + 4 * 128 * 8 * 128, O_CBS = O_CBP + 4 * 2 * 30 * 256, O_CDP = O_CBS + 4 * 128 * 8 * 256,
                 O_CDS = O_CDP + 4 * 2 * 3 * 768, O_SSP = O_CDS + (size_t)4 * 128 * 8 * 768, O_SSS = O_SSP + 4 * 2 * 4 * 64 * 128, O_AV = O_SSS + (size_t)4 * 128 * 4 * 64 * 128,
                 O_END = O_AV + 4 * 128 * 8 * 256;
constexpr size_t MiB = 1u << 20;
constexpr size_t WS_CTL = 0, WS_WIN = 2 * MiB, WS_WOUT = 30 * MiB, WS_PW = 38 * MiB, WS_HB = 40 * MiB, WS_MIX = 74 * MiB, WS_PROJ = 108 * MiB, WS_MIXED = WS_PROJ,
                 WS_YD = 227 * MiB, WS_ST = 243 * MiB, WS_AC = 259 * MiB, WS_CD = WS_AC + 512 * 1024, WS_END = 260 * MiB;
static_assert(WS_WIN + (size_t)DEPTH * PP * DM * 2 <= WS_WOUT && WS_HB + (size_t)NTOK * DM * 2 <= WS_MIX && WS_MIX + (size_t)NTOK * DM * 2 <= WS_PROJ &&
              WS_PROJ + (size_t)NTOK * PP * 2 <= WS_YD && WS_MIXED + (size_t)NTOK * DM * 4 <= WS_YD, "ws map");

struct P {
    const float *x_prompt, *x_sample, *cache_k, *cache_v, *st_conv_b, *st_conv_d, *st_ssm, *norm_pre, *norm_post, *w_in, *w_out, *a_ln_g, *a_ln_b, *a_ws, *a_wb,
        *b_conv_w, *b_conv_b, *b_ln_g, *b_ln_b, *b_pw_w, *b_pw_b, *c_sinks, *d_conv_w, *d_conv_b, *d_dt_bias, *d_a_log, *d_skip, *d_norm_g;
    float* out;
    bf16 *win_t, *wout_t, *hb, *mix, *proj;
    float *mixed, *yd, *states, *acum, *cdec;
    unsigned* ctl;
    int layer, pad;
};

typedef const P __attribute__((address_space(4)))* PCP;
__device__ __forceinline__ PCP getp() { PCP q = (PCP)__builtin_amdgcn_kernarg_segment_ptr(); asm volatile("" : "+s"(q)); return q; }
__device__ __forceinline__ float bf2f(bf16 v) { return __uint_as_float((unsigned)v << 16); }
__device__ __forceinline__ bf16 f2bf(float f) { unsigned u = __float_as_uint(f); return (bf16)((u + 0x7fffu + ((u >> 16) & 1u)) >> 16); }
__device__ __forceinline__ float sigmoid_(float x) { return 1.f / (1.f + __expf(-x)); }
__device__ __forceinline__ float silu_(float x) { return x / (1.f + __expf(-x)); }
__device__ __forceinline__ float gelu_(float x) { const float u = 0.7978845608028654f * (x + 0.044715f * x * x * x); return x / (1.f + __expf(-2.f * u)); }
__device__ __forceinline__ float softplus_(float x) { return x > 20.f ? x : log1pf(__expf(x)); }
__device__ __forceinline__ int tid_() { int t = threadIdx.x; asm volatile("" : "+v"(t)); return t; }
__device__ __forceinline__ float wave_sum(float v) {
#pragma unroll
    for (int o = 1; o < 64; o <<= 1) v += __shfl_xor(v, o);
    return v;
}


__device__ __forceinline__ void norm0_phase(const PCP p) {
    const int tid = tid_(), lane = tid & 63, gw = blockIdx.x * 8 + (tid >> 6), ngw = gridDim.x * 8;
    for (int r = gw; r < NTOK; r += ngw) {
        const float* src = r < NP ? p->x_prompt + (size_t)r * DM : p->x_sample + (size_t)(r - NP) * DM;
        float4 v[4]; float ss = 0.f;
#pragma unroll
        for (int j = 0; j < 4; ++j) { v[j] = ((const float4*)src)[lane + 64 * j]; ss += v[j].x * v[j].x + v[j].y * v[j].y + v[j].z * v[j].z + v[j].w * v[j].w; }
        const float rstd = rsqrtf(wave_sum(ss) * (1.f / DM) + EPS);
#pragma unroll
        for (int j = 0; j < 4; ++j) {
            ((float4*)(p->out + (size_t)r * DM))[lane + 64 * j] = v[j];
            const float4 g = ((const float4*)p->norm_pre)[lane + 64 * j];
            ushort4 o; o.x = f2bf(v[j].x * rstd * g.x); o.y = f2bf(v[j].y * rstd * g.y); o.z = f2bf(v[j].z * rstd * g.z); o.w = f2bf(v[j].w * rstd * g.w);
            ((ushort4*)(p->hb + (size_t)r * DM))[lane + 64 * j] = o;
        }
    }
}
__device__ __forceinline__ void post_phase(const PCP p, const int l) {
    const int tid = tid_(), lane = tid & 63, gw = blockIdx.x * 8 + (tid >> 6), ngw = gridDim.x * 8;
    for (int r = gw; r < NTOK; r += ngw) {
        float4 m[4], x[4]; float ss = 0.f;
#pragma unroll
        for (int j = 0; j < 4; ++j) { m[j] = ((const float4*)(p->mixed + (size_t)r * DM))[lane + 64 * j]; ss += m[j].x * m[j].x + m[j].y * m[j].y + m[j].z * m[j].z + m[j].w * m[j].w; }
        const float rstd = rsqrtf(wave_sum(ss) * (1.f / DM) + EPS);
        float sx = 0.f;
#pragma unroll
        for (int j = 0; j < 4; ++j) {
            x[j] = ((const float4*)(p->out + (size_t)r * DM))[lane + 64 * j];
            const float4 g = ((const float4*)(p->norm_post + l * DM))[lane + 64 * j];
            x[j].x += m[j].x * rstd * g.x; x[j].y += m[j].y * rstd * g.y; x[j].z += m[j].z * rstd * g.z; x[j].w += m[j].w * rstd * g.w;
            sx += x[j].x * x[j].x + x[j].y * x[j].y + x[j].z * x[j].z + x[j].w * x[j].w;
            ((float4*)(p->out + (size_t)r * DM))[lane + 64 * j] = x[j];
        }
        if (l + 1 < DEPTH) {
            const float rx = rsqrtf(wave_sum(sx) * (1.f / DM) + EPS);
#pragma unroll
            for (int j = 0; j < 4; ++j) {
                const float4 g = ((const float4*)(p->norm_pre + (l + 1) * DM))[lane + 64 * j];
                ushort4 o; o.x = f2bf(x[j].x * rx * g.x); o.y = f2bf(x[j].y * rx * g.y); o.z = f2bf(x[j].z * rx * g.z); o.w = f2bf(x[j].w * rx * g.w);
                ((ushort4*)(p->hb + (size_t)r * DM))[lane + 64 * j] = o;
            }
        }
    }
}


__device__ __forceinline__ void mixA_item(const PCP p, const int l, int item, float* lds) {
    const int tid = tid_(), lane = tid & 63, wave = tid >> 6;
    const bool sample = item >= 128;
    const int q = sample ? 8 : 128, row0 = sample ? NP + (item - 128) * 8 : item * 128;
    const float* lng = p->a_ln_g + l * 256; const float* lnb = p->a_ln_b + l * 256;
    for (int t = wave; t < q; t += 8) {
        const bf16* pr = p->proj + (size_t)(row0 + t) * PP + AV + lane * 4;
        const ushort4 raw = *(const ushort4*)pr;
        float g[4] = {gelu_(bf2f(raw.x)), gelu_(bf2f(raw.y)), gelu_(bf2f(raw.z)), gelu_(bf2f(raw.w))};
        const float mean = wave_sum(g[0] + g[1] + g[2] + g[3]) * (1.f / 256.f);
        float d2 = 0.f;
#pragma unroll
        for (int k = 0; k < 4; ++k) { g[k] -= mean; d2 += g[k] * g[k]; }
        const float rstd = rsqrtf(wave_sum(d2) * (1.f / 256.f) + EPS);
#pragma unroll
        for (int k = 0; k < 4; ++k) {
            const float v = g[k] * rstd * lng[lane * 4 + k] + lnb[lane * 4 + k];
            lds[t * 256 + lane * 4 + k] = v;
            if (sample) p->out[O_AV + ((size_t)(l * 128 + (item - 128)) * 8 + t) * 256 + lane * 4 + k] = v;
        }
    }
    __syncthreads();
    const int c = tid & 255, th = tid >> 8, h = c >> 6;
    const float* W = p->a_ws + (size_t)(l * 4 + h) * 128 * 128; const float* wb = p->a_wb + (l * 4 + h) * 128;
    for (int t = th; t < q; t += 2) {
        float acc = 0.f; const float* wr = W + t * 128;
        for (int s = 0; s <= t; ++s) acc += wr[s] * lds[s * 256 + c];
        acc += wb[t];
        const bf16* pr = p->proj + (size_t)(row0 + t) * PP;
        const float u = gelu_(bf2f(pr[AU + c])), z = bf2f(pr[AZ + c]);
        p->mix[(size_t)(row0 + t) * DM + c] = f2bf(u * acc * silu_(z));
    }
    __syncthreads();
}

__device__ __forceinline__ void mixB_item(const PCP p, const int l, int item, float* lds) {
    const int tid = tid_(), lane = tid & 63, wave = tid >> 6;
    float* glu = lds; float* cln = lds + 62 * 256;
    const bool sample = item >= 512;
    const int nt = sample ? 8 : 32, b = sample ? 0 : item >> 8, t0 = sample ? 0 : (item & 255) * 32, n = item - 512;
    const int row0 = sample ? NP + n * 8 : b * SEQ + t0;
    for (int j = wave; j < nt + 30; j += 8) {
        float g[4] = {0.f, 0.f, 0.f, 0.f};
        int srow = -1;
        if (!sample) { const int t = t0 - 30 + j; if (t >= 0) srow = b * SEQ + t; }
        else { if (j >= 30) srow = row0 + j - 30; else { const float4 s4 = *(const float4*)(p->st_conv_b + ((size_t)(l * 128 + n) * 30 + j) * 256 + lane * 4); g[0] = s4.x; g[1] = s4.y; g[2] = s4.z; g[3] = s4.w; } }
        if (srow >= 0) {
            const ushort4 v = *(const ushort4*)(p->proj + (size_t)srow * PP + BV + lane * 4);
            const ushort4 gg = *(const ushort4*)(p->proj + (size_t)srow * PP + BG + lane * 4);
            g[0] = bf2f(v.x) * sigmoid_(bf2f(gg.x)); g[1] = bf2f(v.y) * sigmoid_(bf2f(gg.y)); g[2] = bf2f(v.z) * sigmoid_(bf2f(gg.z)); g[3] = bf2f(v.w) * sigmoid_(bf2f(gg.w));
        }
#pragma unroll
        for (int k = 0; k < 4; ++k) glu[j * 256 + lane * 4 + k] = g[k];
        if (sample && j >= 30) *(float4*)(p->out + O_CBS + ((size_t)(l * 128 + n) * 8 + (j - 30)) * 256 + lane * 4) = make_float4(g[0], g[1], g[2], g[3]);
        if (!sample) { const int t = t0 - 30 + j; if (t >= SEQ - 30) *(float4*)(p->out + O_CBP + ((size_t)(l * 2 + b) * 30 + (t - (SEQ - 30))) * 256 + lane * 4) = make_float4(g[0], g[1], g[2], g[3]); }
    }
    __syncthreads();
    for (int t = wave; t < nt; t += 8) {
        float c[4];
#pragma unroll
        for (int k = 0; k < 4; ++k) c[k] = p->b_conv_b[l * 256 + lane * 4 + k];
#pragma unroll 1
        for (int j = 0; j < 31; ++j) {
            const float4 w = *(const float4*)(p->b_conv_w + (size_t)(l * 31 + j) * 256 + lane * 4);
            const float* gr = glu + (t + j) * 256 + lane * 4;
            c[0] += w.x * gr[0]; c[1] += w.y * gr[1]; c[2] += w.z * gr[2]; c[3] += w.w * gr[3];
        }
        const float mean = wave_sum(c[0] + c[1] + c[2] + c[3]) * (1.f / 256.f);
        float d2 = 0.f;
#pragma unroll
        for (int k = 0; k < 4; ++k) { c[k] -= mean; d2 += c[k] * c[k]; }
        const float rstd = rsqrtf(wave_sum(d2) * (1.f / 256.f) + EPS);
#pragma unroll
        for (int k = 0; k < 4; ++k) cln[t * 256 + lane * 4 + k] = silu_(c[k] * rstd * p->b_ln_g[l * 256 + lane * 4 + k] + p->b_ln_b[l * 256 + lane * 4 + k]);
    }
    __syncthreads();
    const int co = tid & 255, th = tid >> 8, half = nt >> 1, tb = th * half;
    float acc[16];
#pragma unroll
    for (int i = 0; i < 16; ++i) acc[i] = 0.f;
    const float* pw = p->b_pw_w + (size_t)l * 256 * 256 + co;
#pragma unroll 2
    for (int ci = 0; ci < 256; ++ci) {
        const float w = pw[(size_t)ci * 256];
#pragma unroll
        for (int i = 0; i < 16; ++i) if (i < half) acc[i] += cln[(tb + i) * 256 + ci] * w;
    }
    const float pb = p->b_pw_b[l * 256 + co];
#pragma unroll
    for (int i = 0; i < 16; ++i) if (i < half) {
        const size_t row = (size_t)(row0 + tb + i);
        const float z = bf2f(p->proj[row * PP + BZ + co]);
        p->mix[row * DM + 256 + co] = f2bf((acc[i] + pb) * silu_(z));
    }
    __syncthreads();
}

__device__ __forceinline__ void mixC_item(const PCP p, const int l, int item, float* lds) {
    const int tid = tid_();
    float* Ks = lds; float* Vs = lds + 256 * 65;
    const bool sample = item >= 256;
    const int kh = item & 1, b = item >> 7, qb = (item >> 1) & 63, n = (item - 256) >> 1;
    if (!sample) {
        for (int idx = tid; idx < 256 * 64; idx += 512) {
            const int j = idx >> 6, d = idx & 63, pos = (qb - 1) * 128 + j;
            float kv = 0.f, vv = 0.f;
            if (pos >= 0) { const size_t row = (size_t)b * SEQ + pos; kv = bf2f(p->proj[row * PP + CK + kh * 64 + d]); vv = bf2f(p->proj[row * PP + CV + kh * 64 + d]); }
            Ks[j * 65 + d] = kv; Vs[j * 65 + d] = vv;
            if (qb == 63 && j >= 128) { const size_t o = (((size_t)(l * 2 + b) * 128 + (j - 128)) * 2 + kh) * 64 + d; p->out[O_KP + o] = kv; p->out[O_VP + o] = vv; }
        }
    } else {
        for (int idx = tid; idx < 136 * 64; idx += 512) {
            const int j = idx >> 6, d = idx & 63;
            float kv, vv;
            if (j < 128) { const size_t o = ((((size_t)l * 128 + n) * 128 + j) * 2 + kh) * 64 + d; kv = p->cache_k[o]; vv = p->cache_v[o]; }
            else { const size_t row = (size_t)NP + n * 8 + (j - 128); kv = bf2f(p->proj[row * PP + CK + kh * 64 + d]); vv = bf2f(p->proj[row * PP + CV + kh * 64 + d]);
                   const size_t o = (((size_t)(l * 128 + n) * 8 + (j - 128)) * 2 + kh) * 64 + d; p->out[O_KS + o] = kv; p->out[O_VS + o] = vv; }
            Ks[j * 65 + d] = kv; Vs[j * 65 + d] = vv;
        }
    }
    __syncthreads();
    const int nq = sample ? 8 : 128;
    if (tid < 2 * nq) {
        const int qi = tid % nq, g = tid / nq, h = kh * 2 + g;
        const size_t row = sample ? (size_t)NP + n * 8 + qi : (size_t)b * SEQ + qb * 128 + qi;
        float qv[64], o[64];
#pragma unroll
        for (int d = 0; d < 64; ++d) { qv[d] = bf2f(p->proj[row * PP + CQ + h * 64 + d]) * 0.125f; o[d] = 0.f; }
        const float slope = exp2f(-2.f * (float)(h + 1));
        float m = p->c_sinks[l * 4 + h], lsum = 1.f;
        for (int j = qi; j <= qi + 128; ++j) {
            if (!sample && (qb - 1) * 128 + j < 0) continue;
            float s = 0.f;
#pragma unroll
            for (int d = 0; d < 64; ++d) s += qv[d] * Ks[j * 65 + d];
            s -= slope * (float)(qi + 128 - j);
            const float mn = fmaxf(m, s), sc = __expf(m - mn), pe = __expf(s - mn);
            lsum = lsum * sc + pe;
#pragma unroll
            for (int d = 0; d < 64; ++d) o[d] = o[d] * sc + pe * Vs[j * 65 + d];
            m = mn;
        }
        const float inv = 1.f / lsum;
#pragma unroll
        for (int d = 0; d < 64; ++d) {
            const float z = bf2f(p->proj[row * PP + CZ + h * 64 + d]);
            p->mix[row * DM + 512 + h * 64 + d] = f2bf(o[d] * inv * silu_(z));
        }
    }
    __syncthreads();
}

__device__ __forceinline__ void mixD_local_item(const PCP p, const int l, int item, unsigned char* ldsb) {
    const int tid = tid_();
    bf16* Xs = (bf16*)ldsb; bf16* Bs = Xs + 128 * 128; bf16* Cs = Bs + 128 * 128; bf16* Ss = Cs + 128 * 128;
    float* dts = (float*)(Ss + 128 * 128); float* acs = dts + 256; float* wts = acs + 256;
    const int cidx = item >> 1, g = item & 1, b = cidx >> 6, c = cidx & 63, t0 = c * 128; const size_t row0 = (size_t)b * SEQ + t0;
    for (int idx = tid; idx < 128 * 384; idx += 512) {
        const int t = idx / 384, cc = idx % 384, part = cc >> 7, col = cc & 127, xcol = part * 256 + g * 128 + col;
        float acc = p->d_conv_b[l * 768 + xcol];
#pragma unroll
        for (int j = 0; j < 4; ++j) { const int tt = t0 + t - 3 + j; if (tt >= 0) acc += p->d_conv_w[(l * 4 + j) * 768 + xcol] * bf2f(p->proj[((size_t)b * SEQ + tt) * PP + DX + xcol]); }
        const bf16 v = f2bf(silu_(acc));
        (part == 0 ? Xs : part == 1 ? Bs : Cs)[t * 128 + col] = v;
        if (c == 63 && t >= 125) p->out[O_CDP + ((size_t)(l * 2 + b) * 3 + (t - 125)) * 768 + xcol] = bf2f(p->proj[(row0 + t) * PP + DX + xcol]);
    }
    if (tid < 256) { const int h2 = tid >> 7, t = tid & 127, h = 2 * g + h2; dts[h2 * 128 + t] = softplus_(bf2f(p->proj[(row0 + t) * PP + DT + h]) + p->d_dt_bias[l * 4 + h]); }
    __syncthreads();
    if (tid < 2) { const int h = 2 * g + tid; const float a = -__expf(p->d_a_log[l * 4 + h]); float s = 0.f; for (int t = 0; t < 128; ++t) { s += dts[tid * 128 + t] * a; acs[tid * 128 + t] = s; } }
    __syncthreads();
    if (tid < 256) { const int h2 = tid >> 7, t = tid & 127, h = 2 * g + h2; p->acum[(row0 + t) * 4 + h] = acs[h2 * 128 + t]; }
    float gv[32];
    { const int t = tid >> 2;
#pragma unroll
      for (int i = 0; i < 32; ++i) { const int s = (tid & 3) + 4 * i; float acc = 0.f; if (s <= t) {
#pragma unroll 4
          for (int nn = 0; nn < 128; ++nn) acc += bf2f(Cs[t * 128 + nn]) * bf2f(Bs[s * 128 + nn]); } gv[i] = acc; } }
    for (int h2 = 0; h2 < 2; ++h2) {
        const int h = 2 * g + h2; const float aclast = acs[h2 * 128 + 127];
        { const int t = tid >> 2;
#pragma unroll
          for (int i = 0; i < 32; ++i) { const int s = (tid & 3) + 4 * i; Ss[t * 128 + s] = f2bf(s <= t ? gv[i] * __expf(acs[h2 * 128 + t] - acs[h2 * 128 + s]) * dts[h2 * 128 + s] : 0.f); } }
        if (tid < 128) wts[tid] = __expf(aclast - acs[h2 * 128 + tid]) * dts[h2 * 128 + tid];
        __syncthreads();
        { const int pcol = tid & 63, tq = tid >> 6; const float dsk = p->d_skip[l * 4 + h];
#pragma unroll 1
          for (int i = 0; i < 16; ++i) { const int t2 = tq + 8 * i; float acc = 0.f;
#pragma unroll 4
              for (int s = 0; s <= t2; ++s) acc += bf2f(Ss[t2 * 128 + s]) * bf2f(Xs[s * 128 + h2 * 64 + pcol]);
              acc += dsk * bf2f(Xs[t2 * 128 + h2 * 64 + pcol]);
              p->yd[(row0 + t2) * 256 + h * 64 + pcol] = acc; } }
        { const int nn = tid & 127, pq = tid >> 7;
#pragma unroll 1
          for (int i = 0; i < 16; ++i) { const int pp = pq + 4 * i; float acc = 0.f;
#pragma unroll 4
              for (int s = 0; s < 128; ++s) acc += wts[s] * bf2f(Xs[s * 128 + h2 * 64 + pp]) * bf2f(Bs[s * 128 + nn]);
              p->states[((size_t)(cidx * 4 + h) * 64 + pp) * 128 + nn] = acc; } }
        if (tid == 0) p->cdec[cidx * 4 + h] = __expf(aclast);
        __syncthreads();
    }
}
__device__ __forceinline__ void scan_phase(const PCP p, const int l) {
    for (int e = blockIdx.x * 512 + tid_(); e < NB * 4 * 64 * 128; e += gridDim.x * 512) {
        const int b = e >> 15, h = (e >> 13) & 3, pn = e & 8191;
        float hp = 0.f;
        for (int c = 0; c < 64; ++c) { const size_t o = ((size_t)((b * 64 + c) * 4 + h)) * 8192 + pn; const float st = p->states[o]; p->states[o] = hp; hp = hp * p->cdec[(b * 64 + c) * 4 + h] + st; }
        p->out[O_SSP + ((size_t)(l * 2 + b) * 4 + h) * 8192 + pn] = hp;
    }
}
__device__ __forceinline__ void mixD_finish_item(const PCP p, const int l, int item, unsigned char* ldsb) {
    const int tid = tid_(), lane = tid & 63, wave = tid >> 6;
    bf16* Cs = (bf16*)ldsb; float* Hin = (float*)(ldsb + 128 * 128 * 2);
    const int cidx = item >> 1, g = item & 1, b = cidx >> 6, c = cidx & 63, t0 = c * 128; const size_t row0 = (size_t)b * SEQ + t0;
    for (int idx = tid; idx < 128 * 128; idx += 512) {
        const int t = idx >> 7, col = idx & 127, xcol = 512 + g * 128 + col;
        float acc = p->d_conv_b[l * 768 + xcol];
#pragma unroll
        for (int j = 0; j < 4; ++j) { const int tt = t0 + t - 3 + j; if (tt >= 0) acc += p->d_conv_w[(l * 4 + j) * 768 + xcol] * bf2f(p->proj[((size_t)b * SEQ + tt) * PP + DX + xcol]); }
        Cs[t * 128 + col] = f2bf(silu_(acc));
    }
    for (int idx = tid; idx < 128 * 128; idx += 512) { const int hp = idx >> 7, nn = idx & 127; Hin[hp * 129 + nn] = p->states[((size_t)(cidx * 4 + 2 * g + (hp >> 6)) * 64 + (hp & 63)) * 128 + nn]; }
    __syncthreads();
    for (int t = wave; t < 128; t += 8) {
        float y[2]; float ss = 0.f;
#pragma unroll
        for (int k = 0; k < 2; ++k) {
            const int hp = lane + 64 * k, h = 2 * g + k;
            float acc = 0.f;
            for (int nn = 0; nn < 128; ++nn) acc += bf2f(Cs[t * 128 + nn]) * Hin[hp * 129 + nn];
            float v = p->yd[(row0 + t) * 256 + g * 128 + hp] + __expf(p->acum[(row0 + t) * 4 + h]) * acc;
            v *= silu_(bf2f(p->proj[(row0 + t) * PP + DZ + g * 128 + hp]));
            y[k] = v; ss += v * v;
        }
        const float rstd = rsqrtf(wave_sum(ss) * (1.f / 128.f) + EPS);
#pragma unroll
        for (int k = 0; k < 2; ++k) { const int hp = lane + 64 * k; p->mix[(row0 + t) * DM + 768 + g * 128 + hp] = f2bf(y[k] * rstd * p->d_norm_g[l * 256 + g * 128 + hp]); }
    }
    __syncthreads();
}
__device__ __forceinline__ void mixD_sample_item(const PCP p, const int l, int item, float* lds) {
    const int tid = tid_(), lane = tid & 63, wave = tid >> 6;
    float* X8 = lds; float* B8 = X8 + 8 * 128; float* C8 = B8 + 8 * 128; float* Y8 = C8 + 8 * 128; float* dt8 = Y8 + 8 * 128;
    const int n = item >> 1, g = item & 1; const size_t row0 = (size_t)NP + n * 8;
    for (int idx = tid; idx < 8 * 384; idx += 512) {
        const int t = idx / 384, cc = idx % 384, part = cc >> 7, col = cc & 127, xcol = part * 256 + g * 128 + col;
        float acc = p->d_conv_b[l * 768 + xcol];
#pragma unroll
        for (int j = 0; j < 4; ++j) { const int tt = t - 3 + j;
            const float xv = tt >= 0 ? bf2f(p->proj[(row0 + tt) * PP + DX + xcol]) : p->st_conv_d[((size_t)(l * 128 + n) * 3 + (tt + 3)) * 768 + xcol];
            acc += p->d_conv_w[(l * 4 + j) * 768 + xcol] * xv; }
        (part == 0 ? X8 : part == 1 ? B8 : C8)[t * 128 + col] = bf2f(f2bf(silu_(acc)));
        p->out[O_CDS + ((size_t)(l * 128 + n) * 8 + t) * 768 + xcol] = bf2f(p->proj[(row0 + t) * PP + DX + xcol]);
    }
    if (tid < 16) { const int h2 = tid >> 3, t = tid & 7, h = 2 * g + h2; dt8[h2 * 8 + t] = softplus_(bf2f(p->proj[(row0 + t) * PP + DT + h]) + p->d_dt_bias[l * 4 + h]); }
    __syncthreads();
    const int h2 = tid >> 8, pp = (tid >> 2) & 63, nr = (tid & 3) * 32, h = 2 * g + h2;
    const float a = -__expf(p->d_a_log[l * 4 + h]), dsk = p->d_skip[l * 4 + h];
    float hs[32];
    const size_t so = (((size_t)(l * 128 + n) * 4 + h) * 64 + pp) * 128 + nr;
#pragma unroll
    for (int k = 0; k < 32; k += 4) { const float4 v = *(const float4*)(p->st_ssm + so + k); hs[k] = v.x; hs[k + 1] = v.y; hs[k + 2] = v.z; hs[k + 3] = v.w; }
    for (int t = 0; t < 8; ++t) {
        const float dt = dt8[h2 * 8 + t], dA = __expf(dt * a), xv = X8[t * 128 + h2 * 64 + pp] * dt;
        float part = 0.f;
#pragma unroll
        for (int k = 0; k < 32; ++k) { hs[k] = hs[k] * dA + xv * B8[t * 128 + nr + k]; part += C8[t * 128 + nr + k] * hs[k]; }
        part += __shfl_xor(part, 1); part += __shfl_xor(part, 2);
        if ((tid & 3) == 0) Y8[t * 128 + h2 * 64 + pp] = part + dsk * X8[t * 128 + h2 * 64 + pp];
    }
#pragma unroll
    for (int k = 0; k < 32; k += 4) *(float4*)(p->out + O_SSS + so + k) = make_float4(hs[k], hs[k + 1], hs[k + 2], hs[k + 3]);
    __syncthreads();
    { const int t = wave; float y[2]; float ss = 0.f;
#pragma unroll
      for (int k = 0; k < 2; ++k) { const int hp = lane + 64 * k; float v = Y8[t * 128 + hp] * silu_(bf2f(p->proj[(row0 + t) * PP + DZ + g * 128 + hp])); y[k] = v; ss += v * v; }
      const float rstd = rsqrtf(wave_sum(ss) * (1.f / 128.f) + EPS);
#pragma unroll
      for (int k = 0; k < 2; ++k) { const int hp = lane + 64 * k; p->mix[(row0 + t) * DM + 768 + g * 128 + hp] = f2bf(y[k] * rstd * p->d_norm_g[l * 256 + g * 128 + hp]); } }
    __syncthreads();
}


__device__ __forceinline__ unsigned pk2(float lo, float hi) { return (unsigned)f2bf(lo) | ((unsigned)f2bf(hi) << 16); }
__device__ __forceinline__ void transpose_item(const float* W, int K, int N, bf16* WT, float* scr, int kb, int nb, int lane) {
    const int k0 = 64 * kb, n0 = 32 * nb;
#pragma unroll 8
    for (int i = 0; i < 32; ++i) { const int kk = 2 * i + (lane >> 5), n = n0 + (lane & 31); scr[kk * 33 + (lane & 31)] = n < N ? W[(size_t)(k0 + kk) * N + n] : 0.f; }
    asm volatile("s_waitcnt lgkmcnt(0)" ::: "memory");
    const int c = lane & 7;
#pragma unroll
    for (int j = 0; j < 4; ++j) { const int n = (lane >> 3) + 8 * j; const float* s = scr + (8 * c) * 33 + n;
        uint4 o; o.x = pk2(s[0 * 33], s[1 * 33]); o.y = pk2(s[2 * 33], s[3 * 33]); o.z = pk2(s[4 * 33], s[5 * 33]); o.w = pk2(s[6 * 33], s[7 * 33]);
        *(uint4*)(WT + (size_t)(n0 + n) * K + k0 + 8 * c) = o; }
    asm volatile("s_waitcnt lgkmcnt(0)" ::: "memory");
}


#define GAS __attribute__((address_space(1)))
#define LAS __attribute__((address_space(3)))
typedef GAS unsigned gu32;
#define XB_TMO      128
#define XB_XCNT(j)  (256  + 64 * (j))
#define XB_XSUB(j)  (1280 + 64 * (j))
#define XB_XGEN(j)  (2304 + 64 * (j))
#define XB_TOP      3328
#define XB_TOPGEN   3392
#define XCD_BAR_WORDS 3456
#define XB_SPIN_CAP (1u << 18)

__device__ __forceinline__ unsigned xb_ld(unsigned* p)              { return __hip_atomic_load(p, __ATOMIC_RELAXED, __HIP_MEMORY_SCOPE_AGENT); }
__device__ __forceinline__ unsigned xb_add(unsigned* p, unsigned v) { return __hip_atomic_fetch_add(p, v, __ATOMIC_RELAXED, __HIP_MEMORY_SCOPE_AGENT); }
__device__ __forceinline__ unsigned xb_xcc_id() { return (unsigned)__builtin_amdgcn_s_getreg((3 << 11) | 20) & 0xFu; }
#define XB_SPIN(cond, bar) do { unsigned _sp = 0; while (cond) { __builtin_amdgcn_s_sleep(1); \
    if ((++_sp & 255u) == 0u) { if (xb_ld(&(bar)[XB_TMO])) break; if (_sp > XB_SPIN_CAP) { atomicAdd(&(bar)[XB_TMO], 1u); break; } } } } while (0)

struct XcdBarrier {
    unsigned* bar; unsigned x;
    volatile LAS unsigned* st;
};

__device__ __forceinline__ XcdBarrier xcd_barrier_post(unsigned* bar, volatile LAS unsigned* st) {
    XcdBarrier b; b.bar = bar; b.x = xb_xcc_id(); b.st = st;
    if (threadIdx.x == 0) (void)xb_add(&bar[XB_XCNT(b.x)], 1u);
    return b;
}
__device__ __forceinline__ void xcd_barrier_complete(unsigned* bar, unsigned x, unsigned& nloc, unsigned& nx) {
    const unsigned G = gridDim.x * gridDim.y * gridDim.z;
    unsigned sum, cnt, mine, sp = 0u;
    for (;;) {
        sum = 0u; cnt = 0u; mine = 0u;
#pragma unroll
        for (unsigned j = 0; j < 16; ++j) { const unsigned c = xb_ld(&bar[XB_XCNT(j)]); sum += c; cnt += (c > 0u) ? 1u : 0u; mine = (j == x) ? c : mine; }
        if (sum == G) break;
        __builtin_amdgcn_s_sleep(1);
        if ((++sp & 255u) == 0u) { if (xb_ld(&bar[XB_TMO])) break; if (sp > XB_SPIN_CAP) { atomicAdd(&bar[XB_TMO], 1u); break; } }
    }
    nloc = mine > 0u ? mine : 1u; nx = cnt > 0u ? cnt : 1u;
}

__device__ __forceinline__ void xcd_barrier(const XcdBarrier& b) {
    asm volatile("s_waitcnt vmcnt(0)" ::: "memory");
    __syncthreads();
    if (threadIdx.x == 0) {
        unsigned* bar = b.bar;
        __builtin_amdgcn_s_waitcnt(0);
        unsigned nloc = b.st[0], nx = b.st[1];
        if (nloc == 0u) { xcd_barrier_complete(bar, b.x, nloc, nx); b.st[0] = nloc; b.st[1] = nx; }
        const unsigned old = xb_add(&bar[XB_XSUB(b.x)], 1u);
        const unsigned gen = old / nloc;
        if (old + 1u == (gen + 1u) * nloc) {
            __builtin_amdgcn_fence(__ATOMIC_RELEASE, "agent");
            asm volatile("s_waitcnt vmcnt(0)" ::: "memory");
            const unsigned og = xb_add(&bar[XB_TOP], 1u);
            const unsigned tg = og / nx;
            if (og + 1u == (tg + 1u) * nx) xb_add(&bar[XB_TOPGEN], 1u);
            else XB_SPIN(xb_ld(&bar[XB_TOPGEN]) == tg, bar);
            __builtin_amdgcn_fence(__ATOMIC_ACQUIRE, "agent");
            xb_add(&bar[XB_XGEN(b.x)], 1u);
            asm volatile("s_waitcnt vmcnt(0)" ::: "memory");
        } else {
            XB_SPIN(xb_ld(&bar[XB_XGEN(b.x)]) == gen, bar);
            __builtin_amdgcn_fence(__ATOMIC_ACQUIRE, "agent");
            asm volatile("s_waitcnt vmcnt(0)" ::: "memory");
        }
    }
    __syncthreads();
}

constexpr int LDS_BYTES = 147456, MISC_OFF = LDS_BYTES - 256;
#define GRID_SYNC() xcd_barrier(bar)
__global__ void __launch_bounds__(512, 2) mega(P p_unused) {
    extern __shared__ __attribute__((aligned(16))) unsigned char lds[];
    cg::grid_group grid = cg::this_grid();
    const int tid = tid_(), lane = tid & 63, wave = tid >> 6, G = gridDim.x, bid = blockIdx.x;
    (void)tid;
    volatile LAS unsigned* MISC = (volatile LAS unsigned*)((LAS unsigned char*)lds + MISC_OFF);
    if (tid < 64) MISC[tid] = 0u;
    unsigned* const ctl = (unsigned*)getp()->ctl;
    if (bid == 0) for (int i = tid; i < XCD_BAR_WORDS + 64; i += 512) ctl[i] = 0u;
    { const PCP p = getp(); float* scr = (float*)lds + wave * (64 * 33);
      constexpr int I_IN = (DM / 64) * (PP / 32), I_OUT = (DM / 64) * (DM / 32);
      for (int it = bid * 8 + wave; it < DEPTH * (I_IN + I_OUT); it += G * 8) {
          if (it < DEPTH * I_IN) { const int l = it / I_IN, r = it % I_IN; transpose_item(p->w_in + (size_t)l * DM * IN_DIM, DM, IN_DIM, p->win_t + (size_t)l * PP * DM, scr, r / (PP / 32), r % (PP / 32), lane); }
          else { const int q = it - DEPTH * I_IN, l = q / I_OUT, r = q % I_OUT; transpose_item(p->w_out + (size_t)l * DM * DM, DM, DM, p->wout_t + (size_t)l * DM * DM, scr, r / (DM / 32), r % (DM / 32), lane); }
      }
      norm0_phase(p); }
    grid.sync();
    const XcdBarrier bar = xcd_barrier_post(ctl, MISC + 8);
#pragma unroll 1
    for (int l = 0; l < DEPTH; ++l) {
        { const PCP p = getp(); pg8::Gemm g; g.A = p->hb; g.Bt = p->win_t + (size_t)l * PP * DM; g.M = NTOK; g.N = PP; g.K = DM;
          pg8::EpiBf16<0> E; E.O = p->proj; E.ldc = PP; E.bias = nullptr; E.split_cols = 0; E.split_stride = 0; E.scale0 = 1.f;
          pg8::StaticOrder S; S.init(NTOK, PP, G, bid);
          pg8::gemm_phase<pg8::EpiBf16<0>, pg8::StaticOrder, true, true>((PG8_LAS unsigned char*)lds, g, S, E); }
        GRID_SYNC();
        for (int it = bid; it < 256; it += G) mixA_item(getp(), l, it, (float*)lds);
        for (int it = bid; it < 640; it += G) mixB_item(getp(), l, it, (float*)lds);
        for (int it = bid; it < 512; it += G) mixC_item(getp(), l, it, (float*)lds);
        for (int it = bid; it < 256; it += G) mixD_local_item(getp(), l, it, lds);
        for (int it = bid; it < 256; it += G) mixD_sample_item(getp(), l, it, (float*)lds);
        GRID_SYNC();
        scan_phase(getp(), l);
        GRID_SYNC();
        for (int it = bid; it < 256; it += G) mixD_finish_item(getp(), l, it, lds);
        GRID_SYNC();
        { const PCP p = getp(); pg8::Gemm g; g.A = p->mix; g.Bt = p->wout_t + (size_t)l * DM * DM; g.M = NTOK; g.N = DM; g.K = DM;
          pg8::EpiF32 E; E.C = p->mixed; E.ldc = DM; E.bias = nullptr;
          pg8::StaticOrder S; S.init(NTOK, DM, G, bid);
          pg8::gemm_phase<pg8::EpiF32, pg8::StaticOrder, true, true>((PG8_LAS unsigned char*)lds, g, S, E); }
        GRID_SYNC();
        post_phase(getp(), l);
        if (l + 1 < DEPTH) GRID_SYNC();
    }
}

extern "C" void kernel_launch(void* const* d_in, const int* in_sizes, int n_in, void* d_out, int out_size, void* d_ws, size_t ws_size, hipStream_t stream) {
    static int grid = 0;
    if (grid == 0) {
        if (n_in != 28 || in_sizes[0] != NP * DM || (size_t)out_size != O_END || ws_size < WS_END) {
            fprintf(stderr, "kernel_launch: unexpected shapes: n_in %d in0 %d out %d (want %zu) ws %zu (want >= %zu)\n", n_in, n_in > 0 ? in_sizes[0] : -1, out_size, (size_t)O_END, ws_size, (size_t)WS_END);
            grid = -1; return; }
        int dev = 0, cus = 0, per_cu = 0;
        if (hipGetDevice(&dev) != hipSuccess || hipDeviceGetAttribute(&cus, hipDeviceAttributeMultiprocessorCount, dev) != hipSuccess) { fprintf(stderr, "kernel_launch: device query failed\n"); grid = -1; return; }
        if (hipFuncSetAttribute((const void*)mega, hipFuncAttributeMaxDynamicSharedMemorySize, LDS_BYTES) != hipSuccess) { fprintf(stderr, "kernel_launch: hipFuncSetAttribute failed\n"); grid = -1; return; }
        if (hipOccupancyMaxActiveBlocksPerMultiprocessor(&per_cu, (const void*)mega, 512, LDS_BYTES) != hipSuccess || per_cu < 1) { fprintf(stderr, "kernel_launch: occupancy query says %d blocks/CU\n", per_cu); grid = -1; return; }
        (void)hipGetLastError();
        grid = cus;
    }
    if (grid < 0) return;
    unsigned char* ws = (unsigned char*)d_ws;
    P p; memset(&p, 0, sizeof p);
    const float** f = (const float**)&p;
    for (int i = 0; i < 28; ++i) f[i] = (const float*)d_in[i];
    p.out = (float*)d_out;
    p.win_t = (bf16*)(ws + WS_WIN); p.wout_t = (bf16*)(ws + WS_WOUT); p.hb = (bf16*)(ws + WS_HB); p.mix = (bf16*)(ws + WS_MIX); p.proj = (bf16*)(ws + WS_PROJ);
    p.mixed = (float*)(ws + WS_MIXED); p.yd = (float*)(ws + WS_YD); p.states = (float*)(ws + WS_ST); p.acum = (float*)(ws + WS_AC); p.cdec = (float*)(ws + WS_CD); p.ctl = (unsigned*)(ws + WS_CTL);
    void* args[] = {&p};
    const hipError_t e = hipLaunchCooperativeKernel((const void*)mega, dim3(grid), dim3(512), args, LDS_BYTES, stream);
    if (e != hipSuccess) fprintf(stderr, "kernel_launch: cooperative launch failed: %s (grid %d)\n", hipGetErrorString(e), grid);
}
```

```cpp
#include <hip/hip_runtime.h>
#include <cstdio>
#include <cstdint>
#include <cstring>
#include <hip/hip_cooperative_groups.h>
namespace cg = cooperative_groups;
namespace pg8 {
#define PG8_LAS __attribute__((address_space(3)))
typedef unsigned short bf16_t;
typedef short bf16x8 __attribute__((ext_vector_type(8)));
typedef float f32x4 __attribute__((ext_vector_type(4)));
typedef unsigned u32x4 __attribute__((ext_vector_type(4)));
constexpr int BM = 256, BK = 64, HALF = 128, HTB = HALF * BK * 2  , STAGE_BYTES = 8 * HTB, NXCD = 8, WGM = 8;

__host__ __device__ __forceinline__ int lds_byte(int r, int c) { const int st = (r >> 4) * 2 + (c >> 5), rr = r & 15, cc = c & 31, ob = rr * 64 + cc * 2; return st * 1024 + (ob ^ (((ob >> 9) & 1) << 5)); }
__host__ __device__ __forceinline__ void stage_rc(int b, int& R, int& C) { const int st = b / 1024, sb = b % 1024, swz = sb ^ (((sb >> 9) & 1) << 5); R = (st >> 1) * 16 + swz / 64; C = (st & 1) * 32 + (swz % 64) / 2; }
__host__ __device__ __forceinline__ int perm32(int rho) { const int n = rho >> 4, i = rho & 15; return 8 * (i >> 2) + 4 * n + (i & 3); }

struct Unit { int pm, pn; };
struct Gemm { const bf16_t* A; const bf16_t* Bt; int M, N, K; };

struct StaticOrder {
    int nM, nN, nwg, G, c;
    __host__ __device__ void init(int M, int N, int G_, int c_) { nM = M / BM; nN = N / BM; nwg = nM * nN; G = G_; c = c_; }
    __host__ __device__ bool next(int i, Unit& u) const {
        const long L = (long)i * G + c; if (L >= nwg) return false;
        int wgid = (int)L; { const int q = nwg / NXCD, r = nwg % NXCD, xcd = wgid % NXCD, off = wgid / NXCD; wgid = (xcd < r ? xcd * (q + 1) : r * (q + 1) + (xcd - r) * q) + off; }
        const int nig = WGM * nN, gid = wgid / nig, fm = gid * WGM, gsz = (nM - fm) < WGM ? (nM - fm) : WGM;
        u.pm = fm + ((wgid % nig) % gsz); u.pn = (wgid % nig) / gsz; return true;
    }
    __device__ __forceinline__ void a_ready(const Unit&) const {}
    __device__ __forceinline__ void done(const Unit&) const {}
};

__device__ __forceinline__ unsigned cvt_pk_bf16(float lo, float hi) { unsigned r; asm volatile("v_cvt_pk_bf16_f32 %0, %1, %2" : "=v"(r) : "v"(lo), "v"(hi)); return r; }
typedef float f32x2 __attribute__((ext_vector_type(2)));
__device__ __forceinline__ f32x2 gelu_pk(f32x2 v) {
    const f32x2 av = __builtin_elementwise_abs(v), d = av * 0.2316418882f + 1.0f;
    f32x2 t; t.x = __builtin_amdgcn_rcpf(d.x); t.y = __builtin_amdgcn_rcpf(d.y);
    f32x2 q = t * 0.5307027145f + (-0.7265760135f); q = q * t + 0.7107068705f; q = q * t + (-0.142248368f); q = q * t + 0.127414796f; q = q * t;
    const f32x2 s = (v * v) * (-0.72134752044f);
    f32x2 e; e.x = __builtin_amdgcn_exp2f(s.x); e.y = __builtin_amdgcn_exp2f(s.y);
    const f32x2 m = v * (q * e), r = v - m;
    f32x2 o; o.x = v.x < 0.f ? m.x : r.x; o.y = v.y < 0.f ? m.y : r.y; return o;
}

struct EpiF32 {
    static constexpr bool PERM = false, AFTER_DRAIN = false;
    float* C; int ldc; const float* bias;
    __device__ __forceinline__ void operator()(const f32x4 (&acc)[2][2][4][2], const Unit& u, int wr, int wc, int fr, int fq) const {
        const int row0 = u.pm * BM + wr * 64 + fr, col0 = u.pn * BM + wc * 32 + 4 * fq;
        f32x4 bv[2][2];
#pragma unroll
        for (int bj = 0; bj < 2; ++bj)
#pragma unroll
            for (int n = 0; n < 2; ++n) bv[bj][n] = bias ? *(const f32x4*)(bias + col0 + bj * HALF + n * 16) : (f32x4){0.f, 0.f, 0.f, 0.f};
#pragma unroll
        for (int ai = 0; ai < 2; ++ai)
#pragma unroll
            for (int m = 0; m < 4; ++m) { float* rowp = C + (size_t)(row0 + ai * HALF + m * 16) * ldc + col0;
#pragma unroll
                for (int bj = 0; bj < 2; ++bj)
#pragma unroll
                    for (int n = 0; n < 2; ++n) *(f32x4*)(rowp + bj * HALF + n * 16) = acc[ai][bj][m][n] + bv[bj][n]; }
    }
};
template <int ACT  > struct EpiBf16 {
    static constexpr bool PERM = true, AFTER_DRAIN = false; static_assert(ACT == 0 || ACT == 1, "EpiBf16: ACT is 0 (none) or 1 (gelu_pk)");
    bf16_t* O; int ldc; const float* bias; int split_cols; size_t split_stride; float scale0;
    __device__ __forceinline__ void operator()(const f32x4 (&acc)[2][2][4][2], const Unit& u, int wr, int wc, int fr, int fq) const {
        const int row0 = u.pm * BM + wr * 64 + fr; int colt = u.pn * BM; bf16_t* base = O;
        float sc = 1.f; if (split_cols) { const int t = colt / split_cols; base += (size_t)t * split_stride; colt -= t * split_cols; if (t == 0) sc = scale0; }
        const int col0 = colt + wc * 32 + 8 * fq, bcol0 = u.pn * BM + wc * 32 + 8 * fq;
        f32x4 bv[2][2];
#pragma unroll
        for (int bj = 0; bj < 2; ++bj)
#pragma unroll
            for (int n = 0; n < 2; ++n) bv[bj][n] = bias ? *(const f32x4*)(bias + bcol0 + bj * HALF + 4 * n) : (f32x4){0.f, 0.f, 0.f, 0.f};
#pragma unroll
        for (int ai = 0; ai < 2; ++ai)
#pragma unroll
            for (int m = 0; m < 4; ++m) { bf16_t* rowp = base + (size_t)(row0 + ai * HALF + m * 16) * ldc + col0;
#pragma unroll
                for (int bj = 0; bj < 2; ++bj) { f32x4 v0 = acc[ai][bj][m][0] + bv[bj][0], v1 = acc[ai][bj][m][1] + bv[bj][1];
                    if (ACT == 1) { f32x2 a = gelu_pk((f32x2){v0[0], v0[1]}), b = gelu_pk((f32x2){v0[2], v0[3]}), c = gelu_pk((f32x2){v1[0], v1[1]}), d = gelu_pk((f32x2){v1[2], v1[3]});
                        v0 = (f32x4){a.x, a.y, b.x, b.y}; v1 = (f32x4){c.x, c.y, d.x, d.y}; }
                    v0 = v0 * sc; v1 = v1 * sc; u32x4 w; w.x = cvt_pk_bf16(v0[0], v0[1]); w.y = cvt_pk_bf16(v0[2], v0[3]); w.z = cvt_pk_bf16(v1[0], v1[1]); w.w = cvt_pk_bf16(v1[2], v1[3]);
                    *(u32x4*)(rowp + bj * HALF) = w; } }
    }
};

struct PanelStats {
    unsigned* xbuf;
    unsigned* cnt;
    unsigned* tmo;
    int ntn; float eps;
    unsigned code;
    __device__ __forceinline__ bool run(const f32x4 (&v)[2][2][4][2], const Unit& u, int wr, int wc, int fr, int fq, PG8_LAS unsigned char* lds, int wid, int lane) const {
        typedef float f32x2v __attribute__((ext_vector_type(2)));
        PG8_LAS f32x2v* P = (PG8_LAS f32x2v*)lds;
        PG8_LAS f32x2v* S = (PG8_LAS f32x2v*)(lds + 8192);
        PG8_LAS unsigned* flag = (PG8_LAS unsigned*)(lds + 8192 + 2048);
#pragma unroll
        for (int ai = 0; ai < 2; ++ai)
#pragma unroll
            for (int m = 0; m < 4; ++m) {
                float s = 0.f;
#pragma unroll
                for (int bj = 0; bj < 2; ++bj)
#pragma unroll
                    for (int n = 0; n < 2; ++n) { const f32x4 x = v[ai][bj][m][n]; s += (x[0] + x[1]) + (x[2] + x[3]); }
                s += __shfl_xor(s, 16); s += __shfl_xor(s, 32);
                const float mw = s * (1.0f / 64.0f); float q = 0.f;
#pragma unroll
                for (int bj = 0; bj < 2; ++bj)
#pragma unroll
                    for (int n = 0; n < 2; ++n) { const f32x4 d = v[ai][bj][m][n] - mw; q += (d[0] * d[0] + d[1] * d[1]) + (d[2] * d[2] + d[3] * d[3]); }
                q += __shfl_xor(q, 16); q += __shfl_xor(q, 32);
                if (fq == 0) P[(ai * HALF + wr * 64 + m * 16 + fr) * 4 + wc] = (f32x2v){mw, q};
            }
        asm volatile("s_waitcnt lgkmcnt(0)" ::: "memory"); __builtin_amdgcn_s_barrier(); asm volatile("" ::: "memory");
#if defined(BROKEN_EXCHANGE_NO_WAIT)
#warning BROKEN CONTROL BUILD: the row-statistics exchange does not wait; results are wrong by design
        if (blockIdx.x >= 64) { const long long t0_ = clock64(); while (clock64() - t0_ < 60000) __builtin_amdgcn_s_sleep(8); }
#endif
        const int row = wid * 32 + (lane & 31);
        if (lane < 32) {
            const f32x2v a = P[row * 4 + 0], b = P[row * 4 + 1], c = P[row * 4 + 2], d = P[row * 4 + 3];
            const float mt = (a.x + b.x + c.x + d.x) * 0.25f;
            const float da = a.x - mt, db = b.x - mt, dc = c.x - mt, dd = d.x - mt;
            const float m2 = (a.y + b.y) + (c.y + d.y) + 64.0f * ((da * da + db * db) + (dc * dc + dd * dd));
            unsigned long long* slot = (unsigned long long*)xbuf + ((size_t)(u.pm * BM + row) * 4 + u.pn);
            __hip_atomic_store(slot, ((unsigned long long)__float_as_uint(m2) << 32) | __float_as_uint(mt), __ATOMIC_RELAXED, __HIP_MEMORY_SCOPE_AGENT);
        }
        asm volatile("s_waitcnt vmcnt(0)" ::: "memory");
        if (lane == 0) __hip_atomic_fetch_add(cnt + 64 * u.pm, 1u, __ATOMIC_RELAXED, __HIP_MEMORY_SCOPE_AGENT);
        if (wid == 0) {
            bool dead = false; const unsigned long long t0 = __builtin_amdgcn_s_memrealtime(); const unsigned want = 8u * (unsigned)ntn;
            for (;;) {
#if defined(BROKEN_EXCHANGE_NO_WAIT)
                break;
#endif
                if ((unsigned)__builtin_amdgcn_readfirstlane(__hip_atomic_load(cnt + 64 * u.pm, __ATOMIC_RELAXED, __HIP_MEMORY_SCOPE_AGENT)) >= want) break;
                if (__builtin_amdgcn_s_memrealtime() - t0 > 2000000ull) {
                    if (lane == 0) { unsigned expect = 0u; __hip_atomic_compare_exchange_strong(tmo + 1, &expect, code | (unsigned)(u.pm & 0xff), __ATOMIC_RELAXED, __ATOMIC_RELAXED, __HIP_MEMORY_SCOPE_AGENT);
                                     __hip_atomic_store(tmo, 1u, __ATOMIC_RELAXED, __HIP_MEMORY_SCOPE_AGENT); }
                    dead = true; break; }
                __builtin_amdgcn_s_sleep(2);
            }
            __builtin_amdgcn_fence(__ATOMIC_ACQUIRE, "agent");
            if (lane == 0) flag[0] = dead ? 1u : 0u;
        }
        asm volatile("s_waitcnt vmcnt(0) lgkmcnt(0)" ::: "memory"); __builtin_amdgcn_s_barrier(); asm volatile("" ::: "memory");
        const bool bad = flag[0] != 0u;
        if (lane < 32) {
            const unsigned long long* slot = (const unsigned long long*)xbuf + (size_t)(u.pm * BM + row) * 4; float mt[4], m2[4]; float ms = 0.f;
#pragma unroll
            for (int t = 0; t < 4; ++t) { if (t < ntn) { const unsigned long long w = __hip_atomic_load(slot + t, __ATOMIC_RELAXED, __HIP_MEMORY_SCOPE_AGENT); mt[t] = __uint_as_float((unsigned)w); m2[t] = __uint_as_float((unsigned)(w >> 32)); } else { mt[t] = 0.f; m2[t] = 0.f; } ms += mt[t]; }
            const float mean = ms / (float)ntn; float q = 0.f;
#pragma unroll
            for (int t = 0; t < 4; ++t) if (t < ntn) { const float dm = mt[t] - mean; q += m2[t] + 256.0f * dm * dm; }
            S[row] = (f32x2v){mean, 1.0f / sqrtf(q / (256.0f * (float)ntn) + eps)};
        }
        asm volatile("s_waitcnt lgkmcnt(0)" ::: "memory"); __builtin_amdgcn_s_barrier(); asm volatile("" ::: "memory");
        return bad;
    }
};
struct EpiLnRes {
    static constexpr bool PERM = false, AFTER_DRAIN = true;
    const float* base; float* out; int ldc; const float* bias; PanelStats st; unsigned poison;
    __device__ __forceinline__ void fused(f32x4 (&acc)[2][2][4][2], const Unit& u, int wr, int wc, int fr, int fq, PG8_LAS unsigned char* lds, int wid, int lane) const {
        typedef float f32x2v __attribute__((ext_vector_type(2)));
        const PG8_LAS f32x2v* S = (const PG8_LAS f32x2v*)(lds + 8192);
        const int col0 = u.pn * BM + wc * 32 + 4 * fq;
#pragma unroll
        for (int bj = 0; bj < 2; ++bj)
#pragma unroll
            for (int n = 0; n < 2; ++n) { const f32x4 bv = bias ? *(const f32x4*)(bias + col0 + bj * HALF + n * 16) : (f32x4){0.f, 0.f, 0.f, 0.f};
#pragma unroll
                for (int ai = 0; ai < 2; ++ai)
#pragma unroll
                    for (int m = 0; m < 4; ++m) acc[ai][bj][m][n] += bv; }
        f32x4 pre[4][2][2];
#pragma unroll
        for (int m = 0; m < 4; ++m) { const size_t off = (size_t)(u.pm * BM + wr * 64 + m * 16 + fr) * ldc + col0;
#pragma unroll
            for (int bj = 0; bj < 2; ++bj)
#pragma unroll
                for (int n = 0; n < 2; ++n) pre[m][bj][n] = *(const f32x4*)(base + off + bj * HALF + n * 16); }
        const bool bad = st.run(acc, u, wr, wc, fr, fq, lds, wid, lane) || poison != 0u;
        const float qnan = __builtin_nanf("");
#pragma unroll
        for (int ai = 0; ai < 2; ++ai)
#pragma unroll
            for (int m = 0; m < 4; ++m) { const int r = ai * HALF + wr * 64 + m * 16 + fr; const f32x2v sr = S[r]; const size_t off = (size_t)(u.pm * BM + r) * ldc + col0;
#pragma unroll
                for (int bj = 0; bj < 2; ++bj)
#pragma unroll
                    for (int n = 0; n < 2; ++n) { const f32x4 bs = ai == 0 ? pre[m][bj][n] : *(const f32x4*)(base + off + bj * HALF + n * 16); f32x4 o = bs + (acc[ai][bj][m][n] - sr.x) * sr.y;
                        if (bad) o = (f32x4){qnan, qnan, qnan, qnan}; *(f32x4*)(out + off + bj * HALF + n * 16) = o; }
                if (m & 1) asm volatile("" ::: "memory"); }
    }
};
struct EpiLnResLn {
    static constexpr bool PERM = false, AFTER_DRAIN = true;
    const float* base; float* out; bf16_t* xn; int ldc; const float* bias; PanelStats st1, st2; unsigned poison;
    __device__ __forceinline__ void fused(f32x4 (&acc)[2][2][4][2], const Unit& u, int wr, int wc, int fr, int fq, PG8_LAS unsigned char* lds, int wid, int lane) const {
        typedef float f32x2v __attribute__((ext_vector_type(2))); typedef unsigned u32x2v __attribute__((ext_vector_type(2)));
        const PG8_LAS f32x2v* S = (const PG8_LAS f32x2v*)(lds + 8192);
        const int col0 = u.pn * BM + wc * 32 + 4 * fq;
#pragma unroll
        for (int bj = 0; bj < 2; ++bj)
#pragma unroll
            for (int n = 0; n < 2; ++n) { const f32x4 bv = bias ? *(const f32x4*)(bias + col0 + bj * HALF + n * 16) : (f32x4){0.f, 0.f, 0.f, 0.f};
#pragma unroll
                for (int ai = 0; ai < 2; ++ai)
#pragma unroll
                    for (int m = 0; m < 4; ++m) acc[ai][bj][m][n] += bv; }
        bool bad = st1.run(acc, u, wr, wc, fr, fq, lds, wid, lane) || poison != 0u;
        const float qnan = __builtin_nanf("");
#pragma unroll
        for (int ai = 0; ai < 2; ++ai)
#pragma unroll
            for (int m = 0; m < 4; ++m) { const int r = ai * HALF + wr * 64 + m * 16 + fr; const f32x2v sr = S[r]; const size_t off = (size_t)(u.pm * BM + r) * ldc + col0;
#pragma unroll
                for (int bj = 0; bj < 2; ++bj)
#pragma unroll
                    for (int n = 0; n < 2; ++n) { const f32x4 bs = *(const f32x4*)(base + off + bj * HALF + n * 16); acc[ai][bj][m][n] = bs + (acc[ai][bj][m][n] - sr.x) * sr.y; }
                asm volatile("" : "+v"(acc[ai][0][m][0]), "+v"(acc[ai][0][m][1]), "+v"(acc[ai][1][m][0]), "+v"(acc[ai][1][m][1]));
                if (m & 1) asm volatile("" ::: "memory"); }
        const bool bad1 = bad;
        bad = st2.run(acc, u, wr, wc, fr, fq, lds, wid, lane) || bad;
#pragma unroll
        for (int ai = 0; ai < 2; ++ai)
#pragma unroll
            for (int m = 0; m < 4; ++m) { const int r = ai * HALF + wr * 64 + m * 16 + fr; const f32x2v sr = S[r]; const size_t off = (size_t)(u.pm * BM + r) * ldc + col0;
#pragma unroll
                for (int bj = 0; bj < 2; ++bj)
#pragma unroll
                    for (int n = 0; n < 2; ++n) { const f32x4 x1 = acc[ai][bj][m][n]; *(f32x4*)(out + off + bj * HALF + n * 16) = bad1 ? (f32x4){qnan, qnan, qnan, qnan} : x1;
                        const f32x4 o = (x1 - sr.x) * sr.y; u32x2v w; w.x = cvt_pk_bf16(o[0], o[1]); w.y = cvt_pk_bf16(o[2], o[3]);
                        if (bad) { w.x = 0x7fc07fc0u; w.y = 0x7fc07fc0u; } *(u32x2v*)(xn + off + bj * HALF + n * 16) = w; }
                asm volatile("" ::: "memory"); }
    }
};

template <class Epi, class Sched, bool ALIGN_EPI = false, bool SP2 = false>
__device__ __forceinline__ void gemm_phase(PG8_LAS unsigned char* lds, const Gemm g, const Sched& S, const Epi& E) {
    const int tid = threadIdx.x, wid = __builtin_amdgcn_readfirstlane(tid >> 6), lane = tid & 63, wr = wid >> 2, wc = wid & 3, fr = lane & 15, fq = lane >> 4;
    const int K = g.K, nt = K / BK;
    unsigned voffA[2], voffB[2];
#pragma unroll
    for (int i = 0; i < 2; ++i) { int R, C; stage_rc(tid * 16 + i * 8192, R, C); const int Rb = Epi::PERM ? ((R & ~31) + perm32(R & 31)) : R;
        voffA[i] = (unsigned)(R * K + C) * 2u; voffB[i] = (unsigned)(Rb * K + C) * 2u; }
    const size_t kstep = (size_t)(BK * 2);
    const size_t hstep = (size_t)HALF * K * 2;
    const size_t tstep = 2 * hstep;
    const unsigned ldsw = (unsigned)wid * 1024u;
    const int aoff = lds_byte(wr * 64 + fr, fq * 8), boff = lds_byte(wc * 32 + fr, fq * 8);
#define PG8_SA(b, h) (((b) * 2 + (h)) * HTB)
#define PG8_SB(b, h) ((4 + (b) * 2 + (h)) * HTB)
#define PG8_STAGE(bufoff, gbase, voff) do { _Pragma("unroll") for (int _i = 0; _i < 2; ++_i) \
        __builtin_amdgcn_global_load_lds((const unsigned*)((const char*)(gbase) + (voff)[_i]), (PG8_LAS unsigned*)(lds + (bufoff) + ldsw + _i * 8192), 16, 0, 0); } while (0)
#define PG8_LDA(dst, b, h) do { _Pragma("unroll") for (int m = 0; m < 4; ++m) _Pragma("unroll") for (int k = 0; k < 2; ++k) dst[m][k] = *(const PG8_LAS bf16x8*)(lds + PG8_SA(b, h) + aoff + m * 2048 + k * 1024); } while (0)
#define PG8_LDB(dst, b, h) do { _Pragma("unroll") for (int n = 0; n < 2; ++n) _Pragma("unroll") for (int k = 0; k < 2; ++k) dst[n][k] = *(const PG8_LAS bf16x8*)(lds + PG8_SB(b, h) + boff + n * 2048 + k * 1024); } while (0)
#define PG8_MMA(ai, bj, At, Bt) do { __builtin_amdgcn_s_setprio(1); _Pragma("unroll") for (int m = 0; m < 4; ++m) _Pragma("unroll") for (int n = 0; n < 2; ++n) _Pragma("unroll") for (int k = 0; k < 2; ++k) \
        acc[ai][bj][m][n] = __builtin_amdgcn_mfma_f32_16x16x32_bf16(Bt[n][k], At[m][k], acc[ai][bj][m][n], 0, 0, 0); __builtin_amdgcn_s_setprio(0); } while (0)
#define PG8_WAIT_V(n) asm volatile("s_waitcnt vmcnt(" #n ")" ::: "memory")
#define PG8_WAIT_L(n) asm volatile("s_waitcnt lgkmcnt(" #n ")" ::: "memory")
#define PG8_BAR __builtin_amdgcn_s_barrier()
#define PG8_SCHED __builtin_amdgcn_sched_barrier(0)
    Unit cur, nxt; int ui = 0;
    if (!S.next(0, cur)) return;
    f32x4 acc[2][2][4][2];
#pragma unroll
    for (int a = 0; a < 2; ++a)
#pragma unroll
        for (int b = 0; b < 2; ++b)
#pragma unroll
            for (int m = 0; m < 4; ++m)
#pragma unroll
                for (int n = 0; n < 2; ++n) acc[a][b][m][n] = (f32x4){0.f, 0.f, 0.f, 0.f};
    bf16x8 At[4][2], B0[2][2], B1[2][2];
    const char* cA = (const char*)g.A + (size_t)cur.pm * tstep; const char* cB = (const char*)g.Bt + (size_t)cur.pn * tstep;
    S.a_ready(cur);
    if constexpr (SP2) {
        PG8_STAGE(PG8_SB(0, 0), cB, voffB); PG8_STAGE(PG8_SB(0, 1), cB + hstep, voffB); PG8_STAGE(PG8_SA(0, 0), cA, voffA); PG8_STAGE(PG8_SA(0, 1), cA + hstep, voffA);
        if (wr == 1) PG8_BAR;
        PG8_WAIT_V(2); PG8_BAR;
        PG8_STAGE(PG8_SB(1, 0), cB + kstep, voffB); PG8_STAGE(PG8_SA(1, 0), cA + kstep, voffA); PG8_STAGE(PG8_SB(1, 1), cB + hstep + kstep, voffB);
        PG8_WAIT_V(6); PG8_BAR;
    } else {
        PG8_STAGE(PG8_SB(0, 0), cB, voffB); PG8_STAGE(PG8_SA(0, 0), cA, voffA); PG8_STAGE(PG8_SB(0, 1), cB + hstep, voffB); PG8_STAGE(PG8_SA(0, 1), cA + hstep, voffA);
        if (wr == 1) PG8_BAR;
        PG8_WAIT_V(4); PG8_BAR;
        PG8_STAGE(PG8_SB(1, 0), cB + kstep, voffB); PG8_STAGE(PG8_SA(1, 0), cA + kstep, voffA); PG8_STAGE(PG8_SB(1, 1), cB + hstep + kstep, voffB);
        PG8_WAIT_V(6); PG8_BAR;
    }
    for (;;) {
        const bool has_next = S.next(ui + 1, nxt);
        const char* nA = has_next ? (const char*)g.A + (size_t)nxt.pm * tstep : cA; const char* nB = has_next ? (const char*)g.Bt + (size_t)nxt.pn * tstep : cB;
        for (int t = 0; t < nt; t += 2) {
            const bool last = (t == nt - 2);
            const char* a1 = cA + (size_t)(t + 1) * kstep;
            const char* a2 = last ? nA : cA + (size_t)(t + 2) * kstep; const char* b2 = last ? nB : cB + (size_t)(t + 2) * kstep;
            const char* a3 = a2 + kstep; const char* b3 = b2 + kstep;
            if (last && has_next) S.a_ready(nxt);
            if constexpr (SP2) {
            PG8_LDB(B0, 0, 0); PG8_LDB(B1, 0, 1); PG8_SCHED; PG8_LDA(At, 0, 0); PG8_STAGE(PG8_SA(1, 1), a1 + hstep, voffA);
            PG8_WAIT_V(8); PG8_WAIT_L(0); PG8_BAR; PG8_MMA(0, 0, At, B0); PG8_MMA(0, 1, At, B1); PG8_BAR; PG8_SCHED;
            PG8_LDA(At, 0, 1); PG8_STAGE(PG8_SB(0, 0), b2, voffB); PG8_STAGE(PG8_SB(0, 1), b2 + hstep, voffB); PG8_STAGE(PG8_SA(0, 0), a2, voffA);
            PG8_WAIT_V(8); PG8_WAIT_L(0); PG8_BAR; PG8_MMA(1, 0, At, B0); PG8_MMA(1, 1, At, B1); PG8_BAR; PG8_SCHED;
            PG8_LDB(B0, 1, 0); PG8_LDB(B1, 1, 1); PG8_SCHED; PG8_LDA(At, 1, 0); PG8_STAGE(PG8_SA(0, 1), a2 + hstep, voffA);
            PG8_WAIT_V(8); PG8_WAIT_L(0); PG8_BAR; PG8_MMA(0, 0, At, B0); PG8_MMA(0, 1, At, B1); PG8_BAR; PG8_SCHED;
            PG8_LDA(At, 1, 1); PG8_STAGE(PG8_SB(1, 0), b3, voffB); PG8_STAGE(PG8_SB(1, 1), b3 + hstep, voffB); PG8_STAGE(PG8_SA(1, 0), a3, voffA);
            PG8_WAIT_V(8); PG8_WAIT_L(0); PG8_BAR; PG8_MMA(1, 0, At, B0); PG8_MMA(1, 1, At, B1); PG8_BAR; PG8_SCHED;
            } else {
            PG8_LDB(B0, 0, 0); PG8_SCHED; PG8_LDA(At, 0, 0); PG8_STAGE(PG8_SA(1, 1), a1 + hstep, voffA);
            PG8_WAIT_L(8); PG8_BAR; PG8_WAIT_L(0); PG8_MMA(0, 0, At, B0); PG8_BAR; PG8_SCHED;
            PG8_LDB(B1, 0, 1); PG8_STAGE(PG8_SB(0, 0), b2, voffB);
            PG8_BAR; PG8_WAIT_L(0); PG8_MMA(0, 1, At, B1); PG8_BAR;
            PG8_LDA(At, 0, 1); PG8_STAGE(PG8_SA(0, 0), a2, voffA);
            PG8_BAR; PG8_WAIT_L(0); PG8_MMA(1, 0, At, B0); PG8_BAR; PG8_SCHED;
            PG8_STAGE(PG8_SB(0, 1), b2 + hstep, voffB);
            PG8_WAIT_V(6); PG8_BAR; PG8_MMA(1, 1, At, B1); PG8_BAR;
            PG8_LDB(B0, 1, 0); PG8_SCHED; PG8_LDA(At, 1, 0); PG8_STAGE(PG8_SA(0, 1), a2 + hstep, voffA);
            PG8_WAIT_L(8); PG8_BAR; PG8_WAIT_L(0); PG8_MMA(0, 0, At, B0); PG8_BAR; PG8_SCHED;
            PG8_LDB(B1, 1, 1); PG8_STAGE(PG8_SB(1, 0), b3, voffB);
            PG8_BAR; PG8_WAIT_L(0); PG8_MMA(0, 1, At, B1); PG8_BAR;
            PG8_LDA(At, 1, 1); PG8_STAGE(PG8_SA(1, 0), a3, voffA);
            PG8_BAR; PG8_WAIT_L(0); PG8_MMA(1, 0, At, B0); PG8_BAR; PG8_SCHED;
            PG8_STAGE(PG8_SB(1, 1), b3 + hstep, voffB);
            PG8_WAIT_V(6); PG8_BAR; PG8_MMA(1, 1, At, B1); PG8_BAR;
            }
        }
        if constexpr (ALIGN_EPI) { if (wr == 0) PG8_BAR; }
        if constexpr (!Epi::AFTER_DRAIN) { E(acc, cur, wr, wc, fr, fq); S.done(cur); }
        if (!has_next) break;
#pragma unroll
        for (int a = 0; a < 2; ++a)
#pragma unroll
            for (int b = 0; b < 2; ++b)
#pragma unroll
                for (int m = 0; m < 4; ++m)
#pragma unroll
                    for (int n = 0; n < 2; ++n) acc[a][b][m][n] = (f32x4){0.f, 0.f, 0.f, 0.f};
        cur = nxt; cA = nA; cB = nB; ++ui;
        if constexpr (ALIGN_EPI) { if (wr == 1) PG8_BAR; }
    }
    PG8_WAIT_V(0);
    if constexpr (!ALIGN_EPI) { if (wr == 0) PG8_BAR; }
    PG8_BAR;
    if constexpr (Epi::AFTER_DRAIN) { E.fused(acc, cur, wr, wc, fr, fq, lds, wid, lane); S.done(cur); }
#undef PG8_SA
#undef PG8_SB
#undef PG8_STAGE
#undef PG8_LDA
#undef PG8_LDB
#undef PG8_MMA
#undef PG8_WAIT_V
#undef PG8_WAIT_L
#undef PG8_BAR
#undef PG8_SCHED
}
}

typedef unsigned short bf16;
constexpr int DM = 1024, SEQ = 8192, NB = 2, DEPTH = 4, SB = 128, SL = 8;
constexpr int NP = NB * SEQ;
constexpr int NS = SB * SL;
constexpr int NTOK = NP + NS;
constexpr int IN_DIM = 3332, PP = 3584;
constexpr int AU = 0, AV = 256, AZ = 512, BV = 768, BG = 1024, BZ = 1280, CQ = 1536, CK = 1792, CV = 1920, CZ = 2048, DZ = 2304, DX = 2560, DT = 3328;
constexpr float EPS = 1e-6f;
constexpr size_t O_YP = 0, O_YS = O_YP + (size_t)NP * DM, O_KP = O_YS + (size_t)NS * DM, O_KS = O_KP + 4 * 2 * 128 * 128, O_VP = O_KS + 4 * 128 * 8 * 128,
                 O_VS = O_VP + 4 * 2 * 128 * 128, O_CBP = O_VS + 4 * 128 * 8 * 128, O_CBS = O_CBP + 4 * 2 * 30 * 256, O_CDP = O_CBS + 4 * 128 * 8 * 256,
                 O_CDS = O_CDP + 4 * 2 * 3 * 768, O_SSP = O_CDS + (size_t)4 * 128 * 8 * 768, O_SSS = O_SSP + 4 * 2 * 4 * 64 * 128, O_AV = O_SSS + (size_t)4 * 128 * 4 * 64 * 128,
                 O_END = O_AV + 4 * 128 * 8 * 256;
constexpr size_t MiB = 1u << 20;
constexpr size_t WS_CTL = 0, WS_WIN = 2 * MiB, WS_WOUT = 30 * MiB, WS_PW = 38 * MiB, WS_HB = 40 * MiB, WS_MIX = 74 * MiB, WS_PROJ = 108 * MiB, WS_MIXED = WS_PROJ,
                 WS_YD = 227 * MiB, WS_ST = 243 * MiB, WS_AC = 259 * MiB, WS_CD = WS_AC + 512 * 1024, WS_CS = 260 * MiB, WS_END = 268 * MiB;
static_assert(WS_WIN + (size_t)DEPTH * PP * DM * 2 <= WS_WOUT && WS_HB + (size_t)NTOK * DM * 2 <= WS_MIX && WS_MIX + (size_t)NTOK * DM * 2 <= WS_PROJ &&
              WS_PROJ + (size_t)NTOK * PP * 2 <= WS_YD && WS_MIXED + (size_t)NTOK * DM * 4 <= WS_YD, "ws map");

struct P {
    const float *x_prompt, *x_sample, *cache_k, *cache_v, *st_conv_b, *st_conv_d, *st_ssm, *norm_pre, *norm_post, *w_in, *w_out, *a_ln_g, *a_ln_b, *a_ws, *a_wb,
        *b_conv_w, *b_conv_b, *b_ln_g, *b_ln_b, *b_pw_w, *b_pw_b, *c_sinks, *d_conv_w, *d_conv_b, *d_dt_bias, *d_a_log, *d_skip, *d_norm_g;
    float* out;
    bf16 *win_t, *wout_t, *hb, *mix, *proj, *cs;
    float *mixed, *yd, *states, *acum, *cdec;
    unsigned* ctl;
    int layer, pad;
};

typedef const P __attribute__((address_space(4)))* PCP;
__device__ __forceinline__ PCP getp() { PCP q = (PCP)__builtin_amdgcn_kernarg_segment_ptr(); asm volatile("" : "+s"(q)); return q; }
__device__ __forceinline__ float bf2f(bf16 v) { return __uint_as_float((unsigned)v << 16); }
__device__ __forceinline__ bf16 f2bf(float f) { unsigned u = __float_as_uint(f); return (bf16)((u + 0x7fffu + ((u >> 16) & 1u)) >> 16); }
__device__ __forceinline__ float sigmoid_(float x) { return 1.f / (1.f + __expf(-x)); }
__device__ __forceinline__ float silu_(float x) { return x / (1.f + __expf(-x)); }
__device__ __forceinline__ float gelu_(float x) { const float u = 0.7978845608028654f * (x + 0.044715f * x * x * x); return x / (1.f + __expf(-2.f * u)); }
__device__ __forceinline__ float softplus_(float x) { return x > 20.f ? x : log1pf(__expf(x)); }
__device__ __forceinline__ int tid_() { int t = threadIdx.x; asm volatile("" : "+v"(t)); return t; }
__device__ __forceinline__ float wave_sum(float v) {
#pragma unroll
    for (int o = 1; o < 64; o <<= 1) v += __shfl_xor(v, o);
    return v;
}


#define LAS __attribute__((address_space(3)))
typedef short bf16x8 __attribute__((ext_vector_type(8)));
typedef short s16x4 __attribute__((ext_vector_type(4)));
typedef float f32x4 __attribute__((ext_vector_type(4)));
typedef LAS unsigned char* lptr;
typedef unsigned u32x4 __attribute__((ext_vector_type(4)));
typedef unsigned u32x2 __attribute__((ext_vector_type(2)));
#define MFMA16(a, b, c) __builtin_amdgcn_mfma_f32_16x16x32_bf16((a), (b), (c), 0, 0, 0)
__device__ __forceinline__ bf16x8 frag_row(lptr base, int ldb, int r0, int k0, int lane) { return *(const LAS bf16x8*)(base + (r0 + (lane & 15)) * ldb + (k0 + 8 * (lane >> 4)) * 2); }
__device__ __forceinline__ s16x4 tr16(lptr a) { return __builtin_bit_cast(s16x4, __builtin_amdgcn_ds_read_tr16_b64_v4i16((LAS s16x4*)a)); }
__device__ __forceinline__ bf16x8 frag_tr(lptr base, int ldb, int k0, int j0, int lane) {
    const int i = lane & 15; lptr a = base + (k0 + 8 * (lane >> 4) + (i >> 2)) * ldb + (j0 + 4 * (i & 3)) * 2;
    const s16x4 lo = tr16(a), hi = tr16(a + 4 * ldb);
    return __builtin_shufflevector(lo, hi, 0, 1, 2, 3, 4, 5, 6, 7);
}
__device__ __forceinline__ unsigned pk2(float lo, float hi) { return (unsigned)f2bf(lo) | ((unsigned)f2bf(hi) << 16); }
__device__ __forceinline__ void unpack8(const u32x4 v, float (&f)[8]) {
    f[0] = __uint_as_float(v.x << 16); f[1] = __uint_as_float(v.x & 0xffff0000u); f[2] = __uint_as_float(v.y << 16); f[3] = __uint_as_float(v.y & 0xffff0000u);
    f[4] = __uint_as_float(v.z << 16); f[5] = __uint_as_float(v.z & 0xffff0000u); f[6] = __uint_as_float(v.w << 16); f[7] = __uint_as_float(v.w & 0xffff0000u);
}
__device__ __forceinline__ u32x4 pack8(const float (&f)[8]) { u32x4 o; o.x = pk2(f[0], f[1]); o.y = pk2(f[2], f[3]); o.z = pk2(f[4], f[5]); o.w = pk2(f[6], f[7]); return o; }

__device__ __forceinline__ void norm0_phase(const PCP p) {
    const int tid = tid_(), lane = tid & 63, gw = blockIdx.x * 8 + (tid >> 6), ngw = gridDim.x * 8;
    for (int r = gw; r < NTOK; r += ngw) {
        const float* src = r < NP ? p->x_prompt + (size_t)r * DM : p->x_sample + (size_t)(r - NP) * DM;
        float4 v[4]; float ss = 0.f;
#pragma unroll
        for (int j = 0; j < 4; ++j) { v[j] = ((const float4*)src)[lane + 64 * j]; ss += v[j].x * v[j].x + v[j].y * v[j].y + v[j].z * v[j].z + v[j].w * v[j].w; }
        const float rstd = rsqrtf(wave_sum(ss) * (1.f / DM) + EPS);
#pragma unroll
        for (int j = 0; j < 4; ++j) {
            ((float4*)(p->out + (size_t)r * DM))[lane + 64 * j] = v[j];
            const float4 g = ((const float4*)p->norm_pre)[lane + 64 * j];
            ushort4 o; o.x = f2bf(v[j].x * rstd * g.x); o.y = f2bf(v[j].y * rstd * g.y); o.z = f2bf(v[j].z * rstd * g.z); o.w = f2bf(v[j].w * rstd * g.w);
            ((ushort4*)(p->hb + (size_t)r * DM))[lane + 64 * j] = o;
        }
    }
}
__device__ __forceinline__ void post_phase(const PCP p, const int l) {
    const int tid = tid_(), lane = tid & 63, gw = blockIdx.x * 8 + (tid >> 6), ngw = gridDim.x * 8;
    for (int r = gw; r < NTOK; r += ngw) {
        float4 m[4], x[4]; float ss = 0.f;
#pragma unroll
        for (int j = 0; j < 4; ++j) { m[j] = ((const float4*)(p->mixed + (size_t)r * DM))[lane + 64 * j]; ss += m[j].x * m[j].x + m[j].y * m[j].y + m[j].z * m[j].z + m[j].w * m[j].w; }
        const float rstd = rsqrtf(wave_sum(ss) * (1.f / DM) + EPS);
        float sx = 0.f;
#pragma unroll
        for (int j = 0; j < 4; ++j) {
            x[j] = ((const float4*)(p->out + (size_t)r * DM))[lane + 64 * j];
            const float4 g = ((const float4*)(p->norm_post + l * DM))[lane + 64 * j];
            x[j].x += m[j].x * rstd * g.x; x[j].y += m[j].y * rstd * g.y; x[j].z += m[j].z * rstd * g.z; x[j].w += m[j].w * rstd * g.w;
            sx += x[j].x * x[j].x + x[j].y * x[j].y + x[j].z * x[j].z + x[j].w * x[j].w;
            ((float4*)(p->out + (size_t)r * DM))[lane + 64 * j] = x[j];
        }
        if (l + 1 < DEPTH) {
            const float rx = rsqrtf(wave_sum(sx) * (1.f / DM) + EPS);
#pragma unroll
            for (int j = 0; j < 4; ++j) {
                const float4 g = ((const float4*)(p->norm_pre + (l + 1) * DM))[lane + 64 * j];
                ushort4 o; o.x = f2bf(x[j].x * rx * g.x); o.y = f2bf(x[j].y * rx * g.y); o.z = f2bf(x[j].z * rx * g.z); o.w = f2bf(x[j].w * rx * g.w);
                ((ushort4*)(p->hb + (size_t)r * DM))[lane + 64 * j] = o;
            }
        }
    }
}


__device__ __forceinline__ void mixA_item(const PCP p, const int l, int item, float* lds) {
    const int tid = tid_(), lane = tid & 63, wave = tid >> 6;
    const bool sample = item >= 128;
    const int q = sample ? 8 : 128, row0 = sample ? NP + (item - 128) * 8 : item * 128;
    const float* lng = p->a_ln_g + l * 256; const float* lnb = p->a_ln_b + l * 256;
    for (int t = wave; t < q; t += 8) {
        const bf16* pr = p->proj + (size_t)(row0 + t) * PP + AV + lane * 4;
        const ushort4 raw = *(const ushort4*)pr;
        float g[4] = {gelu_(bf2f(raw.x)), gelu_(bf2f(raw.y)), gelu_(bf2f(raw.z)), gelu_(bf2f(raw.w))};
        const float mean = wave_sum(g[0] + g[1] + g[2] + g[3]) * (1.f / 256.f);
        float d2 = 0.f;
#pragma unroll
        for (int k = 0; k < 4; ++k) { g[k] -= mean; d2 += g[k] * g[k]; }
        const float rstd = rsqrtf(wave_sum(d2) * (1.f / 256.f) + EPS);
#pragma unroll
        for (int k = 0; k < 4; ++k) {
            const float v = g[k] * rstd * lng[lane * 4 + k] + lnb[lane * 4 + k];
            lds[t * 256 + lane * 4 + k] = v;
            if (sample) p->out[O_AV + ((size_t)(l * 128 + (item - 128)) * 8 + t) * 256 + lane * 4 + k] = v;
        }
    }
    __syncthreads();
    const int c = tid & 255, th = tid >> 8, h = c >> 6;
    const float* W = p->a_ws + (size_t)(l * 4 + h) * 128 * 128; const float* wb = p->a_wb + (l * 4 + h) * 128;
    for (int t = th; t < q; t += 2) {
        float acc = 0.f; const float* wr = W + t * 128;
        for (int s = 0; s <= t; ++s) acc += wr[s] * lds[s * 256 + c];
        acc += wb[t];
        const bf16* pr = p->proj + (size_t)(row0 + t) * PP;
        const float u = gelu_(bf2f(pr[AU + c])), z = bf2f(pr[AZ + c]);
        p->mix[(size_t)(row0 + t) * DM + c] = f2bf(u * acc * silu_(z));
    }
    __syncthreads();
}

__device__ __forceinline__ void mixB_item(const PCP p, const int l, int item, float* lds) {
    const int tid = tid_(), lane = tid & 63, wave = tid >> 6;
    float* glu = lds; float* cln = lds + 62 * 256;
    const bool sample = item >= 512;
    const int nt = sample ? 8 : 32, b = sample ? 0 : item >> 8, t0 = sample ? 0 : (item & 255) * 32, n = item - 512;
    const int row0 = sample ? NP + n * 8 : b * SEQ + t0;
    for (int j = wave; j < nt + 30; j += 8) {
        float g[4] = {0.f, 0.f, 0.f, 0.f};
        int srow = -1;
        if (!sample) { const int t = t0 - 30 + j; if (t >= 0) srow = b * SEQ + t; }
        else { if (j >= 30) srow = row0 + j - 30; else { const float4 s4 = *(const float4*)(p->st_conv_b + ((size_t)(l * 128 + n) * 30 + j) * 256 + lane * 4); g[0] = s4.x; g[1] = s4.y; g[2] = s4.z; g[3] = s4.w; } }
        if (srow >= 0) {
            const ushort4 v = *(const ushort4*)(p->proj + (size_t)srow * PP + BV + lane * 4);
            const ushort4 gg = *(const ushort4*)(p->proj + (size_t)srow * PP + BG + lane * 4);
            g[0] = bf2f(v.x) * sigmoid_(bf2f(gg.x)); g[1] = bf2f(v.y) * sigmoid_(bf2f(gg.y)); g[2] = bf2f(v.z) * sigmoid_(bf2f(gg.z)); g[3] = bf2f(v.w) * sigmoid_(bf2f(gg.w));
        }
#pragma unroll
        for (int k = 0; k < 4; ++k) glu[j * 256 + lane * 4 + k] = g[k];
        if (sample && j >= 30) *(float4*)(p->out + O_CBS + ((size_t)(l * 128 + n) * 8 + (j - 30)) * 256 + lane * 4) = make_float4(g[0], g[1], g[2], g[3]);
        if (!sample) { const int t = t0 - 30 + j; if (t >= SEQ - 30) *(float4*)(p->out + O_CBP + ((size_t)(l * 2 + b) * 30 + (t - (SEQ - 30))) * 256 + lane * 4) = make_float4(g[0], g[1], g[2], g[3]); }
    }
    __syncthreads();
    for (int t = wave; t < nt; t += 8) {
        float c[4];
#pragma unroll
        for (int k = 0; k < 4; ++k) c[k] = p->b_conv_b[l * 256 + lane * 4 + k];
#pragma unroll 1
        for (int j = 0; j < 31; ++j) {
            const float4 w = *(const float4*)(p->b_conv_w + (size_t)(l * 31 + j) * 256 + lane * 4);
            const float* gr = glu + (t + j) * 256 + lane * 4;
            c[0] += w.x * gr[0]; c[1] += w.y * gr[1]; c[2] += w.z * gr[2]; c[3] += w.w * gr[3];
        }
        const float mean = wave_sum(c[0] + c[1] + c[2] + c[3]) * (1.f / 256.f);
        float d2 = 0.f;
#pragma unroll
        for (int k = 0; k < 4; ++k) { c[k] -= mean; d2 += c[k] * c[k]; }
        const float rstd = rsqrtf(wave_sum(d2) * (1.f / 256.f) + EPS);
#pragma unroll
        for (int k = 0; k < 4; ++k) cln[t * 256 + lane * 4 + k] = silu_(c[k] * rstd * p->b_ln_g[l * 256 + lane * 4 + k] + p->b_ln_b[l * 256 + lane * 4 + k]);
    }
    __syncthreads();
    const int co = tid & 255, th = tid >> 8, half = nt >> 1, tb = th * half;
    float acc[16];
#pragma unroll
    for (int i = 0; i < 16; ++i) acc[i] = 0.f;
    const float* pw = p->b_pw_w + (size_t)l * 256 * 256 + co;
#pragma unroll 2
    for (int ci = 0; ci < 256; ++ci) {
        const float w = pw[(size_t)ci * 256];
#pragma unroll
        for (int i = 0; i < 16; ++i) if (i < half) acc[i] += cln[(tb + i) * 256 + ci] * w;
    }
    const float pb = p->b_pw_b[l * 256 + co];
#pragma unroll
    for (int i = 0; i < 16; ++i) if (i < half) {
        const size_t row = (size_t)(row0 + tb + i);
        const float z = bf2f(p->proj[row * PP + BZ + co]);
        p->mix[row * DM + 256 + co] = f2bf((acc[i] + pb) * silu_(z));
    }
    __syncthreads();
}

__device__ __forceinline__ void mixC_item(const PCP p, const int l, int item, float* lds) {
    const int tid = tid_();
    float* Ks = lds; float* Vs = lds + 256 * 65;
    const bool sample = item >= 256;
    const int kh = item & 1, b = item >> 7, qb = (item >> 1) & 63, n = (item - 256) >> 1;
    if (!sample) {
        for (int idx = tid; idx < 256 * 64; idx += 512) {
            const int j = idx >> 6, d = idx & 63, pos = (qb - 1) * 128 + j;
            float kv = 0.f, vv = 0.f;
            if (pos >= 0) { const size_t row = (size_t)b * SEQ + pos; kv = bf2f(p->proj[row * PP + CK + kh * 64 + d]); vv = bf2f(p->proj[row * PP + CV + kh * 64 + d]); }
            Ks[j * 65 + d] = kv; Vs[j * 65 + d] = vv;
            if (qb == 63 && j >= 128) { const size_t o = (((size_t)(l * 2 + b) * 128 + (j - 128)) * 2 + kh) * 64 + d; p->out[O_KP + o] = kv; p->out[O_VP + o] = vv; }
        }
    } else {
        for (int idx = tid; idx < 136 * 64; idx += 512) {
            const int j = idx >> 6, d = idx & 63;
            float kv, vv;
            if (j < 128) { const size_t o = ((((size_t)l * 128 + n) * 128 + j) * 2 + kh) * 64 + d; kv = p->cache_k[o]; vv = p->cache_v[o]; }
            else { const size_t row = (size_t)NP + n * 8 + (j - 128); kv = bf2f(p->proj[row * PP + CK + kh * 64 + d]); vv = bf2f(p->proj[row * PP + CV + kh * 64 + d]);
                   const size_t o = (((size_t)(l * 128 + n) * 8 + (j - 128)) * 2 + kh) * 64 + d; p->out[O_KS + o] = kv; p->out[O_VS + o] = vv; }
            Ks[j * 65 + d] = kv; Vs[j * 65 + d] = vv;
        }
    }
    __syncthreads();
    const int nq = sample ? 8 : 128;
    if (tid < 2 * nq) {
        const int qi = tid % nq, g = tid / nq, h = kh * 2 + g;
        const size_t row = sample ? (size_t)NP + n * 8 + qi : (size_t)b * SEQ + qb * 128 + qi;
        float qv[64], o[64];
#pragma unroll
        for (int d = 0; d < 64; ++d) { qv[d] = bf2f(p->proj[row * PP + CQ + h * 64 + d]) * 0.125f; o[d] = 0.f; }
        const float slope = exp2f(-2.f * (float)(h + 1));
        float m = p->c_sinks[l * 4 + h], lsum = 1.f;
        for (int j = qi; j <= qi + 128; ++j) {
            if (!sample && (qb - 1) * 128 + j < 0) continue;
            float s = 0.f;
#pragma unroll
            for (int d = 0; d < 64; ++d) s += qv[d] * Ks[j * 65 + d];
            s -= slope * (float)(qi + 128 - j);
            const float mn = fmaxf(m, s), sc = __expf(m - mn), pe = __expf(s - mn);
            lsum = lsum * sc + pe;
#pragma unroll
            for (int d = 0; d < 64; ++d) o[d] = o[d] * sc + pe * Vs[j * 65 + d];
            m = mn;
        }
        const float inv = 1.f / lsum;
#pragma unroll
        for (int d = 0; d < 64; ++d) {
            const float z = bf2f(p->proj[row * PP + CZ + h * 64 + d]);
            p->mix[row * DM + 512 + h * 64 + d] = f2bf(o[d] * inv * silu_(z));
        }
    }
    __syncthreads();
}

__device__ __forceinline__ void mixD_local_item(const PCP p, const int l, int item, unsigned char* ldsb) {
    const int tid = tid_();
    bf16* Xs = (bf16*)ldsb; bf16* Bs = Xs + 128 * 128; bf16* Cs = Bs + 128 * 128; bf16* Ss = Cs + 128 * 128;
    float* dts = (float*)(Ss + 128 * 128); float* acs = dts + 256; float* wts = acs + 256;
    const int cidx = item >> 1, g = item & 1, b = cidx >> 6, c = cidx & 63, t0 = c * 128; const size_t row0 = (size_t)b * SEQ + t0;
    for (int idx = tid; idx < 128 * 384; idx += 512) {
        const int t = idx / 384, cc = idx % 384, part = cc >> 7, col = cc & 127, xcol = part * 256 + g * 128 + col;
        float acc = p->d_conv_b[l * 768 + xcol];
#pragma unroll
        for (int j = 0; j < 4; ++j) { const int tt = t0 + t - 3 + j; if (tt >= 0) acc += p->d_conv_w[(l * 4 + j) * 768 + xcol] * bf2f(p->proj[((size_t)b * SEQ + tt) * PP + DX + xcol]); }
        const bf16 v = f2bf(silu_(acc));
        (part == 0 ? Xs : part == 1 ? Bs : Cs)[t * 128 + col] = v;
        if (c == 63 && t >= 125) p->out[O_CDP + ((size_t)(l * 2 + b) * 3 + (t - 125)) * 768 + xcol] = bf2f(p->proj[(row0 + t) * PP + DX + xcol]);
    }
    if (tid < 256) { const int h2 = tid >> 7, t = tid & 127, h = 2 * g + h2; dts[h2 * 128 + t] = softplus_(bf2f(p->proj[(row0 + t) * PP + DT + h]) + p->d_dt_bias[l * 4 + h]); }
    __syncthreads();
    if (tid < 2) { const int h = 2 * g + tid; const float a = -__expf(p->d_a_log[l * 4 + h]); float s = 0.f; for (int t = 0; t < 128; ++t) { s += dts[tid * 128 + t] * a; acs[tid * 128 + t] = s; } }
    __syncthreads();
    if (tid < 256) { const int h2 = tid >> 7, t = tid & 127, h = 2 * g + h2; p->acum[(row0 + t) * 4 + h] = acs[h2 * 128 + t]; }
    float gv[32];
    { const int t = tid >> 2;
#pragma unroll
      for (int i = 0; i < 32; ++i) { const int s = (tid & 3) + 4 * i; float acc = 0.f; if (s <= t) {
#pragma unroll 4
          for (int nn = 0; nn < 128; ++nn) acc += bf2f(Cs[t * 128 + nn]) * bf2f(Bs[s * 128 + nn]); } gv[i] = acc; } }
    for (int h2 = 0; h2 < 2; ++h2) {
        const int h = 2 * g + h2; const float aclast = acs[h2 * 128 + 127];
        { const int t = tid >> 2;
#pragma unroll
          for (int i = 0; i < 32; ++i) { const int s = (tid & 3) + 4 * i; Ss[t * 128 + s] = f2bf(s <= t ? gv[i] * __expf(acs[h2 * 128 + t] - acs[h2 * 128 + s]) * dts[h2 * 128 + s] : 0.f); } }
        if (tid < 128) wts[tid] = __expf(aclast - acs[h2 * 128 + tid]) * dts[h2 * 128 + tid];
        __syncthreads();
        { const int pcol = tid & 63, tq = tid >> 6; const float dsk = p->d_skip[l * 4 + h];
#pragma unroll 1
          for (int i = 0; i < 16; ++i) { const int t2 = tq + 8 * i; float acc = 0.f;
#pragma unroll 4
              for (int s = 0; s <= t2; ++s) acc += bf2f(Ss[t2 * 128 + s]) * bf2f(Xs[s * 128 + h2 * 64 + pcol]);
              acc += dsk * bf2f(Xs[t2 * 128 + h2 * 64 + pcol]);
              p->yd[(row0 + t2) * 256 + h * 64 + pcol] = acc; } }
        { const int nn = tid & 127, pq = tid >> 7;
#pragma unroll 1
          for (int i = 0; i < 16; ++i) { const int pp = pq + 4 * i; float acc = 0.f;
#pragma unroll 4
              for (int s = 0; s < 128; ++s) acc += wts[s] * bf2f(Xs[s * 128 + h2 * 64 + pp]) * bf2f(Bs[s * 128 + nn]);
              p->states[((size_t)(cidx * 4 + h) * 64 + pp) * 128 + nn] = acc; } }
        if (tid == 0) p->cdec[cidx * 4 + h] = __expf(aclast);
        __syncthreads();
    }
}
__device__ __forceinline__ void scan_phase(const PCP p, const int l) {
    for (int e = blockIdx.x * 512 + tid_(); e < NB * 4 * 64 * 128; e += gridDim.x * 512) {
        const int b = e >> 15, h = (e >> 13) & 3, pn = e & 8191;
        float hp = 0.f;
        for (int c = 0; c < 64; ++c) { const size_t o = ((size_t)((b * 64 + c) * 4 + h)) * 8192 + pn; const float st = p->states[o]; p->states[o] = hp; hp = hp * p->cdec[(b * 64 + c) * 4 + h] + st; }
        p->out[O_SSP + ((size_t)(l * 2 + b) * 4 + h) * 8192 + pn] = hp;
    }
}
__device__ __forceinline__ void mixD_finish_item(const PCP p, const int l, int item, unsigned char* ldsb) {
    const int tid = tid_(), lane = tid & 63, wave = tid >> 6;
    bf16* Cs = (bf16*)ldsb; float* Hin = (float*)(ldsb + 128 * 128 * 2);
    const int cidx = item >> 1, g = item & 1, b = cidx >> 6, c = cidx & 63, t0 = c * 128; const size_t row0 = (size_t)b * SEQ + t0;
    for (int idx = tid; idx < 128 * 128; idx += 512) {
        const int t = idx >> 7, col = idx & 127, xcol = 512 + g * 128 + col;
        float acc = p->d_conv_b[l * 768 + xcol];
#pragma unroll
        for (int j = 0; j < 4; ++j) { const int tt = t0 + t - 3 + j; if (tt >= 0) acc += p->d_conv_w[(l * 4 + j) * 768 + xcol] * bf2f(p->proj[((size_t)b * SEQ + tt) * PP + DX + xcol]); }
        Cs[t * 128 + col] = f2bf(silu_(acc));
    }
    for (int idx = tid; idx < 128 * 128; idx += 512) { const int hp = idx >> 7, nn = idx & 127; Hin[hp * 129 + nn] = p->states[((size_t)(cidx * 4 + 2 * g + (hp >> 6)) * 64 + (hp & 63)) * 128 + nn]; }
    __syncthreads();
    for (int t = wave; t < 128; t += 8) {
        float y[2]; float ss = 0.f;
#pragma unroll
        for (int k = 0; k < 2; ++k) {
            const int hp = lane + 64 * k, h = 2 * g + k;
            float acc = 0.f;
            for (int nn = 0; nn < 128; ++nn) acc += bf2f(Cs[t * 128 + nn]) * Hin[hp * 129 + nn];
            float v = p->yd[(row0 + t) * 256 + g * 128 + hp] + __expf(p->acum[(row0 + t) * 4 + h]) * acc;
            v *= silu_(bf2f(p->proj[(row0 + t) * PP + DZ + g * 128 + hp]));
            y[k] = v; ss += v * v;
        }
        const float rstd = rsqrtf(wave_sum(ss) * (1.f / 128.f) + EPS);
#pragma unroll
        for (int k = 0; k < 2; ++k) { const int hp = lane + 64 * k; p->mix[(row0 + t) * DM + 768 + g * 128 + hp] = f2bf(y[k] * rstd * p->d_norm_g[l * 256 + g * 128 + hp]); }
    }
    __syncthreads();
}
__device__ __forceinline__ void mixD_sample_item(const PCP p, const int l, int item, float* lds) {
    const int tid = tid_(), lane = tid & 63, wave = tid >> 6;
    float* X8 = lds; float* B8 = X8 + 8 * 128; float* C8 = B8 + 8 * 128; float* Y8 = C8 + 8 * 128; float* dt8 = Y8 + 8 * 128;
    const int n = item >> 1, g = item & 1; const size_t row0 = (size_t)NP + n * 8;
    for (int idx = tid; idx < 8 * 384; idx += 512) {
        const int t = idx / 384, cc = idx % 384, part = cc >> 7, col = cc & 127, xcol = part * 256 + g * 128 + col;
        float acc = p->d_conv_b[l * 768 + xcol];
#pragma unroll
        for (int j = 0; j < 4; ++j) { const int tt = t - 3 + j;
            const float xv = tt >= 0 ? bf2f(p->proj[(row0 + tt) * PP + DX + xcol]) : p->st_conv_d[((size_t)(l * 128 + n) * 3 + (tt + 3)) * 768 + xcol];
            acc += p->d_conv_w[(l * 4 + j) * 768 + xcol] * xv; }
        (part == 0 ? X8 : part == 1 ? B8 : C8)[t * 128 + col] = bf2f(f2bf(silu_(acc)));
        p->out[O_CDS + ((size_t)(l * 128 + n) * 8 + t) * 768 + xcol] = bf2f(p->proj[(row0 + t) * PP + DX + xcol]);
    }
    if (tid < 16) { const int h2 = tid >> 3, t = tid & 7, h = 2 * g + h2; dt8[h2 * 8 + t] = softplus_(bf2f(p->proj[(row0 + t) * PP + DT + h]) + p->d_dt_bias[l * 4 + h]); }
    __syncthreads();
    const int h2 = tid >> 8, pp = (tid >> 2) & 63, nr = (tid & 3) * 32, h = 2 * g + h2;
    const float a = -__expf(p->d_a_log[l * 4 + h]), dsk = p->d_skip[l * 4 + h];
    float hs[32];
    const size_t so = (((size_t)(l * 128 + n) * 4 + h) * 64 + pp) * 128 + nr;
#pragma unroll
    for (int k = 0; k < 32; k += 4) { const float4 v = *(const float4*)(p->st_ssm + so + k); hs[k] = v.x; hs[k + 1] = v.y; hs[k + 2] = v.z; hs[k + 3] = v.w; }
    for (int t = 0; t < 8; ++t) {
        const float dt = dt8[h2 * 8 + t], dA = __expf(dt * a), xv = X8[t * 128 + h2 * 64 + pp] * dt;
        float part = 0.f;
#pragma unroll
        for (int k = 0; k < 32; ++k) { hs[k] = hs[k] * dA + xv * B8[t * 128 + nr + k]; part += C8[t * 128 + nr + k] * hs[k]; }
        part += __shfl_xor(part, 1); part += __shfl_xor(part, 2);
        if ((tid & 3) == 0) Y8[t * 128 + h2 * 64 + pp] = part + dsk * X8[t * 128 + h2 * 64 + pp];
    }
#pragma unroll
    for (int k = 0; k < 32; k += 4) *(float4*)(p->out + O_SSS + so + k) = make_float4(hs[k], hs[k + 1], hs[k + 2], hs[k + 3]);
    __syncthreads();
    { const int t = wave; float y[2]; float ss = 0.f;
#pragma unroll
      for (int k = 0; k < 2; ++k) { const int hp = lane + 64 * k; float v = Y8[t * 128 + hp] * silu_(bf2f(p->proj[(row0 + t) * PP + DZ + g * 128 + hp])); y[k] = v; ss += v * v; }
      const float rstd = rsqrtf(wave_sum(ss) * (1.f / 128.f) + EPS);
#pragma unroll
      for (int k = 0; k < 2; ++k) { const int hp = lane + 64 * k; p->mix[(row0 + t) * DM + 768 + g * 128 + hp] = f2bf(y[k] * rstd * p->d_norm_g[l * 256 + g * 128 + hp]); } }
    __syncthreads();
}


constexpr int LD_D = 272, R_C = 0, R_B = 128 * LD_D, R_X = 2 * 128 * LD_D, R_W = 3 * 128 * LD_D, SM_D = 4 * 128 * LD_D;
__device__ __forceinline__ void ssd_local_item(const PCP p, const int l, int item, lptr lds) {
    const int tid = tid_(), lane = tid & 63, wave = __builtin_amdgcn_readfirstlane(tid >> 6);
    LAS float* dts = (LAS float*)(lds + SM_D); LAS float* acs = dts + 256; LAS float* wts = acs + 256;
    const int cidx = item >> 1, g = item & 1, b = cidx >> 6, c = cidx & 63, t0 = c * 128; const size_t row0 = (size_t)b * SEQ + t0;
    if (tid < 384) {
        const int cg = tid % 48, rl = tid / 48, part = cg >> 4, col = (cg & 15) * 8, xcol = part * 256 + g * 128 + col;
        float w[4][8], bias[8];
#pragma unroll
        for (int j = 0; j < 4; ++j) { const float4 a = *(const float4*)(p->d_conv_w + (size_t)(l * 4 + j) * 768 + xcol), bq = *(const float4*)(p->d_conv_w + (size_t)(l * 4 + j) * 768 + xcol + 4);
            w[j][0] = a.x; w[j][1] = a.y; w[j][2] = a.z; w[j][3] = a.w; w[j][4] = bq.x; w[j][5] = bq.y; w[j][6] = bq.z; w[j][7] = bq.w; }
        { const float4 a = *(const float4*)(p->d_conv_b + l * 768 + xcol), bq = *(const float4*)(p->d_conv_b + l * 768 + xcol + 4);
          bias[0] = a.x; bias[1] = a.y; bias[2] = a.z; bias[3] = a.w; bias[4] = bq.x; bias[5] = bq.y; bias[6] = bq.z; bias[7] = bq.w; }
        const lptr dst = lds + (part == 0 ? R_X : part == 1 ? R_B : R_C) + col * 2;
        const bf16* src = p->proj + row0 * PP + DX + xcol;
#pragma unroll 1
        for (int k = 0; k < 4; ++k) {
            const int r4 = 4 * (rl + 8 * k);
            u32x4 raw[7];
#pragma unroll
            for (int j = 0; j < 7; ++j) { const int t = r4 - 3 + j; raw[j] = (t0 + t >= 0) ? *(const u32x4*)(src + (long)t * PP) : (u32x4){0u, 0u, 0u, 0u}; }
            float x[7][8];
#pragma unroll
            for (int j = 0; j < 7; ++j) unpack8(raw[j], x[j]);
#pragma unroll
            for (int r = 0; r < 4; ++r) {
                float o[8];
#pragma unroll
                for (int e = 0; e < 8; ++e) o[e] = silu_(bias[e] + w[0][e] * x[r][e] + w[1][e] * x[r + 1][e] + w[2][e] * x[r + 2][e] + w[3][e] * x[r + 3][e]);
                const u32x4 pk = pack8(o);
                *(LAS u32x4*)(dst + (r4 + r) * LD_D) = pk;
                if (part == 2) *(u32x4*)(p->cs + (row0 + r4 + r) * 256 + g * 128 + col) = pk;
            }
            if (c == 63 && r4 == 124) {
#pragma unroll
                for (int r = 1; r < 4; ++r) { float* o = p->out + O_CDP + ((size_t)(l * 2 + b) * 3 + (r - 1)) * 768 + xcol;
                    *(float4*)o = make_float4(x[r + 3][0], x[r + 3][1], x[r + 3][2], x[r + 3][3]); *(float4*)(o + 4) = make_float4(x[r + 3][4], x[r + 3][5], x[r + 3][6], x[r + 3][7]); }
            }
        }
    } else {
        const int t = tid - 384;
#pragma unroll
        for (int h2 = 0; h2 < 2; ++h2) { const int h = 2 * g + h2; dts[h2 * 128 + t] = softplus_(bf2f(p->proj[(row0 + t) * PP + DT + h]) + p->d_dt_bias[l * 4 + h]); }
    }
    __syncthreads();
    if (wave < 2) {
        const int h2 = wave, h = 2 * g + h2; const float a = -__expf(p->d_a_log[l * 4 + h]);
        const float d0 = dts[h2 * 128 + 2 * lane], d1 = dts[h2 * 128 + 2 * lane + 1];
        const float x0 = d0 * a, x1 = d1 * a; float tot = x0 + x1;
#pragma unroll
        for (int o = 1; o < 64; o <<= 1) { const float v = __shfl_up(tot, o); if (lane >= o) tot += v; }
        const float last = __shfl(tot, 63);
        const float a0 = tot - x1, a1 = tot;
        acs[h2 * 128 + 2 * lane] = a0; acs[h2 * 128 + 2 * lane + 1] = a1;
        wts[h2 * 128 + 2 * lane] = __expf(last - a0) * d0; wts[h2 * 128 + 2 * lane + 1] = __expf(last - a1) * d1;
        p->acum[(row0 + 2 * lane) * 4 + h] = a0; p->acum[(row0 + 2 * lane + 1) * 4 + h] = a1;
        if (lane == 0) p->cdec[cidx * 4 + h] = __expf(last);
    }
    __syncthreads();
    f32x4 gacc[5];
#pragma unroll
    for (int k = 0; k < 5; ++k) {
        gacc[k] = (f32x4){0.f, 0.f, 0.f, 0.f};
        int pi = wave + 8 * k;
        if (pi < 36) { int i = 0; while (pi > i) { pi -= i + 1; ++i; } const int j = pi;
#pragma unroll
            for (int ks = 0; ks < 4; ++ks) gacc[k] = MFMA16(frag_row(lds + R_B, LD_D, 16 * j, 32 * ks, lane), frag_row(lds + R_C, LD_D, 16 * i, 32 * ks, lane), gacc[k]); }
    }
#pragma unroll
    for (int k = 0; k < 4; ++k) { const int ch = tid + 512 * k, s = ch >> 4, cc = (ch & 15) * 8; float f[8]; unpack8(*(const LAS u32x4*)(lds + R_X + s * LD_D + cc * 2), f); const float ws_ = wts[(cc >> 6) * 128 + s];
#pragma unroll
        for (int e = 0; e < 8; ++e) f[e] *= ws_;
        *(LAS u32x4*)(lds + R_W + s * LD_D + cc * 2) = pack8(f); }
    __syncthreads();
#pragma unroll
    for (int h2 = 0; h2 < 2; ++h2) {
        const int h = 2 * g + h2;
#pragma unroll
        for (int k = 0; k < 5; ++k) {
            int pi = wave + 8 * k;
            if (pi < 36) { int i = 0; while (pi > i) { pi -= i + 1; ++i; } const int j = pi;
                const int t = 16 * i + (lane & 15), s0 = 16 * j + 4 * (lane >> 4);
                const float at = acs[h2 * 128 + t]; const f32x4 as4 = *(const LAS f32x4*)(acs + h2 * 128 + s0), dt4 = *(const LAS f32x4*)(dts + h2 * 128 + s0);
                float v[4];
#pragma unroll
                for (int r = 0; r < 4; ++r) v[r] = (s0 + r <= t) ? gacc[k][r] * __expf(at - as4[r]) * dt4[r] : 0.f;
                *(LAS u32x2*)(lds + R_C + t * LD_D + s0 * 2) = (u32x2){pk2(v[0], v[1]), pk2(v[2], v[3])};
                if (j == i && (i & 1) == 0) *(LAS u32x2*)(lds + R_C + t * LD_D + (s0 + 16) * 2) = (u32x2){0u, 0u};
            }
        }
        __syncthreads();
        { const float dsk = p->d_skip[l * 4 + h];
#pragma unroll
          for (int tt = 0; tt < 2; ++tt) {
              const int i = tt == 0 ? (wave >> 1) : 7 - (wave >> 1), nks = (i >> 1) + 1;
#pragma unroll
              for (int pq = 0; pq < 2; ++pq) {
                  const int pt = 2 * (wave & 1) + pq; f32x4 acc = (f32x4){0.f, 0.f, 0.f, 0.f};
                  for (int ks = 0; ks < nks; ++ks) acc = MFMA16(frag_tr(lds + R_X, LD_D, 32 * ks, h2 * 64 + 16 * pt, lane), frag_row(lds + R_C, LD_D, 16 * i, 32 * ks, lane), acc);
                  const int t = 16 * i + (lane & 15), pp = 16 * pt + 4 * (lane >> 4);
                  const u32x2 xr = *(const LAS u32x2*)(lds + R_X + t * LD_D + (h2 * 64 + pp) * 2);
                  float4 o; o.x = acc[0] + dsk * __uint_as_float(xr.x << 16); o.y = acc[1] + dsk * __uint_as_float(xr.x & 0xffff0000u); o.z = acc[2] + dsk * __uint_as_float(xr.y << 16); o.w = acc[3] + dsk * __uint_as_float(xr.y & 0xffff0000u);
                  *(float4*)(p->yd + (row0 + t) * 256 + h * 64 + pp) = o;
              }
          } }
        if (h2 == 0) {
            bf16x8 bt[4];
#pragma unroll
            for (int ks = 0; ks < 4; ++ks) bt[ks] = frag_tr(lds + R_B, LD_D, 32 * ks, 16 * wave, lane);
#pragma unroll
            for (int pt = 0; pt < 8; ++pt) {
                f32x4 acc = (f32x4){0.f, 0.f, 0.f, 0.f};
#pragma unroll
                for (int ks = 0; ks < 4; ++ks) acc = MFMA16(bt[ks], frag_tr(lds + R_W, LD_D, 32 * ks, 16 * pt, lane), acc);
                const int p2 = 16 * pt + (lane & 15), n0 = 16 * wave + 4 * (lane >> 4);
                *(float4*)(p->states + ((size_t)(cidx * 4 + 2 * g + (p2 >> 6)) * 64 + (p2 & 63)) * 128 + n0) = make_float4(acc[0], acc[1], acc[2], acc[3]);
            }
        }
        __syncthreads();
    }
}
__device__ __forceinline__ void ssd_finish_item(const PCP p, const int l, int item, lptr lds) {
    const int tid = tid_(), lane = tid & 63, wave = __builtin_amdgcn_readfirstlane(tid >> 6);
    const int cidx = item >> 1, g = item & 1, b = cidx >> 6, c = cidx & 63, t0 = c * 128; const size_t row0 = (size_t)b * SEQ + t0;
#pragma unroll
    for (int k = 0; k < 4; ++k) { const int ch = tid + 512 * k, r = ch >> 4, cc = (ch & 15) * 8;
        *(LAS u32x4*)(lds + R_C + r * LD_D + cc * 2) = *(const u32x4*)(p->cs + (row0 + r) * 256 + g * 128 + cc);
        const float* hp = p->states + ((size_t)(cidx * 4 + 2 * g + (r >> 6)) * 64 + (r & 63)) * 128 + cc;
        const float4 a = *(const float4*)hp, bq = *(const float4*)(hp + 4);
        *(LAS u32x4*)(lds + R_B + r * LD_D + cc * 2) = (u32x4){pk2(a.x, a.y), pk2(a.z, a.w), pk2(bq.x, bq.y), pk2(bq.z, bq.w)}; }
    __syncthreads();
    const int t = 16 * wave + (lane & 15); const size_t row = row0 + t;
    bf16x8 cf[4];
#pragma unroll
    for (int ks = 0; ks < 4; ++ks) cf[ks] = frag_row(lds + R_C, LD_D, 16 * wave, 32 * ks, lane);
    const float e0 = __expf(p->acum[row * 4 + 2 * g]), e1 = __expf(p->acum[row * 4 + 2 * g + 1]);
    float v[8][4]; float ss = 0.f;
#pragma unroll
    for (int pt = 0; pt < 8; ++pt) {
        f32x4 acc = (f32x4){0.f, 0.f, 0.f, 0.f};
#pragma unroll
        for (int ks = 0; ks < 4; ++ks) acc = MFMA16(frag_row(lds + R_B, LD_D, 16 * pt, 32 * ks, lane), cf[ks], acc);
        const int p2 = 16 * pt + 4 * (lane >> 4); const float ex = pt < 4 ? e0 : e1;
        const float4 y0 = *(const float4*)(p->yd + row * 256 + g * 128 + p2);
        const uint2 zr = *(const uint2*)(p->proj + row * PP + DZ + g * 128 + p2);
        v[pt][0] = (y0.x + ex * acc[0]) * silu_(__uint_as_float(zr.x << 16)); v[pt][1] = (y0.y + ex * acc[1]) * silu_(__uint_as_float(zr.x & 0xffff0000u));
        v[pt][2] = (y0.z + ex * acc[2]) * silu_(__uint_as_float(zr.y << 16)); v[pt][3] = (y0.w + ex * acc[3]) * silu_(__uint_as_float(zr.y & 0xffff0000u));
        ss += v[pt][0] * v[pt][0] + v[pt][1] * v[pt][1] + v[pt][2] * v[pt][2] + v[pt][3] * v[pt][3];
    }
    ss += __shfl_xor(ss, 16); ss += __shfl_xor(ss, 32);
    const float rstd = rsqrtf(ss * (1.f / 128.f) + EPS);
#pragma unroll
    for (int pt = 0; pt < 8; ++pt) { const int p2 = 16 * pt + 4 * (lane >> 4); const float4 ng = *(const float4*)(p->d_norm_g + l * 256 + g * 128 + p2);
        *(uint2*)(p->mix + row * DM + 768 + g * 128 + p2) = make_uint2(pk2(v[pt][0] * rstd * ng.x, v[pt][1] * rstd * ng.y), pk2(v[pt][2] * rstd * ng.z, v[pt][3] * rstd * ng.w)); }
    __syncthreads();
}

__device__ __forceinline__ void transpose_item(const float* W, int K, int N, bf16* WT, float* scr, int kb, int nb, int lane) {
    const int k0 = 64 * kb, n0 = 32 * nb;
#pragma unroll 8
    for (int i = 0; i < 32; ++i) { const int kk = 2 * i + (lane >> 5), n = n0 + (lane & 31); scr[kk * 33 + (lane & 31)] = n < N ? W[(size_t)(k0 + kk) * N + n] : 0.f; }
    asm volatile("s_waitcnt lgkmcnt(0)" ::: "memory");
    const int c = lane & 7;
#pragma unroll
    for (int j = 0; j < 4; ++j) { const int n = (lane >> 3) + 8 * j; const float* s = scr + (8 * c) * 33 + n;
        uint4 o; o.x = pk2(s[0 * 33], s[1 * 33]); o.y = pk2(s[2 * 33], s[3 * 33]); o.z = pk2(s[4 * 33], s[5 * 33]); o.w = pk2(s[6 * 33], s[7 * 33]);
        *(uint4*)(WT + (size_t)(n0 + n) * K + k0 + 8 * c) = o; }
    asm volatile("s_waitcnt lgkmcnt(0)" ::: "memory");
}


#define GAS __attribute__((address_space(1)))
typedef GAS unsigned gu32;
#define XB_TMO      128
#define XB_XCNT(j)  (256  + 64 * (j))
#define XB_XSUB(j)  (1280 + 64 * (j))
#define XB_XGEN(j)  (2304 + 64 * (j))
#define XB_TOP      3328
#define XB_TOPGEN   3392
#define XCD_BAR_WORDS 3456
#define XB_SPIN_CAP (1u << 18)

__device__ __forceinline__ unsigned xb_ld(unsigned* p)              { return __hip_atomic_load(p, __ATOMIC_RELAXED, __HIP_MEMORY_SCOPE_AGENT); }
__device__ __forceinline__ unsigned xb_add(unsigned* p, unsigned v) { return __hip_atomic_fetch_add(p, v, __ATOMIC_RELAXED, __HIP_MEMORY_SCOPE_AGENT); }
__device__ __forceinline__ unsigned xb_xcc_id() { return (unsigned)__builtin_amdgcn_s_getreg((3 << 11) | 20) & 0xFu; }
#define XB_SPIN(cond, bar) do { unsigned _sp = 0; while (cond) { __builtin_amdgcn_s_sleep(1); \
    if ((++_sp & 255u) == 0u) { if (xb_ld(&(bar)[XB_TMO])) break; if (_sp > XB_SPIN_CAP) { atomicAdd(&(bar)[XB_TMO], 1u); break; } } } } while (0)

struct XcdBarrier {
    unsigned* bar; unsigned x;
    volatile LAS unsigned* st;
};

__device__ __forceinline__ XcdBarrier xcd_barrier_post(unsigned* bar, volatile LAS unsigned* st) {
    XcdBarrier b; b.bar = bar; b.x = xb_xcc_id(); b.st = st;
    if (threadIdx.x == 0) (void)xb_add(&bar[XB_XCNT(b.x)], 1u);
    return b;
}
__device__ __forceinline__ void xcd_barrier_complete(unsigned* bar, unsigned x, unsigned& nloc, unsigned& nx) {
    const unsigned G = gridDim.x * gridDim.y * gridDim.z;
    unsigned sum, cnt, mine, sp = 0u;
    for (;;) {
        sum = 0u; cnt = 0u; mine = 0u;
#pragma unroll
        for (unsigned j = 0; j < 16; ++j) { const unsigned c = xb_ld(&bar[XB_XCNT(j)]); sum += c; cnt += (c > 0u) ? 1u : 0u; mine = (j == x) ? c : mine; }
        if (sum == G) break;
        __builtin_amdgcn_s_sleep(1);
        if ((++sp & 255u) == 0u) { if (xb_ld(&bar[XB_TMO])) break; if (sp > XB_SPIN_CAP) { atomicAdd(&bar[XB_TMO], 1u); break; } }
    }
    nloc = mine > 0u ? mine : 1u; nx = cnt > 0u ? cnt : 1u;
}

__device__ __forceinline__ void xcd_barrier(const XcdBarrier& b) {
    asm volatile("s_waitcnt vmcnt(0)" ::: "memory");
    __syncthreads();
    if (threadIdx.x == 0) {
        unsigned* bar = b.bar;
        __builtin_amdgcn_s_waitcnt(0);
        unsigned nloc = b.st[0], nx = b.st[1];
        if (nloc == 0u) { xcd_barrier_complete(bar, b.x, nloc, nx); b.st[0] = nloc; b.st[1] = nx; }
        const unsigned old = xb_add(&bar[XB_XSUB(b.x)], 1u);
        const unsigned gen = old / nloc;
        if (old + 1u == (gen + 1u) * nloc) {
            __builtin_amdgcn_fence(__ATOMIC_RELEASE, "agent");
            asm volatile("s_waitcnt vmcnt(0)" ::: "memory");
            const unsigned og = xb_add(&bar[XB_TOP], 1u);
            const unsigned tg = og / nx;
            if (og + 1u == (tg + 1u) * nx) xb_add(&bar[XB_TOPGEN], 1u);
            else XB_SPIN(xb_ld(&bar[XB_TOPGEN]) == tg, bar);
            __builtin_amdgcn_fence(__ATOMIC_ACQUIRE, "agent");
            xb_add(&bar[XB_XGEN(b.x)], 1u);
            asm volatile("s_waitcnt vmcnt(0)" ::: "memory");
        } else {
            XB_SPIN(xb_ld(&bar[XB_XGEN(b.x)]) == gen, bar);
            __builtin_amdgcn_fence(__ATOMIC_ACQUIRE, "agent");
            asm volatile("s_waitcnt vmcnt(0)" ::: "memory");
        }
    }
    __syncthreads();
}

constexpr int LDS_BYTES = 147456, MISC_OFF = LDS_BYTES - 256;
#define GRID_SYNC() xcd_barrier(bar)
__global__ void __launch_bounds__(512, 2) mega(P p_unused) {
    extern __shared__ __attribute__((aligned(16))) unsigned char lds[];
    cg::grid_group grid = cg::this_grid();
    const int tid = tid_(), lane = tid & 63, wave = tid >> 6, G = gridDim.x, bid = blockIdx.x;
    (void)tid;
    volatile LAS unsigned* MISC = (volatile LAS unsigned*)((LAS unsigned char*)lds + MISC_OFF);
    if (tid < 64) MISC[tid] = 0u;
    unsigned* const ctl = (unsigned*)getp()->ctl;
    if (bid == 0) for (int i = tid; i < XCD_BAR_WORDS + 64; i += 512) ctl[i] = 0u;
    { const PCP p = getp(); float* scr = (float*)lds + wave * (64 * 33);
      constexpr int I_IN = (DM / 64) * (PP / 32), I_OUT = (DM / 64) * (DM / 32);
      for (int it = bid * 8 + wave; it < DEPTH * (I_IN + I_OUT); it += G * 8) {
          if (it < DEPTH * I_IN) { const int l = it / I_IN, r = it % I_IN; transpose_item(p->w_in + (size_t)l * DM * IN_DIM, DM, IN_DIM, p->win_t + (size_t)l * PP * DM, scr, r / (PP / 32), r % (PP / 32), lane); }
          else { const int q = it - DEPTH * I_IN, l = q / I_OUT, r = q % I_OUT; transpose_item(p->w_out + (size_t)l * DM * DM, DM, DM, p->wout_t + (size_t)l * DM * DM, scr, r / (DM / 32), r % (DM / 32), lane); }
      }
      norm0_phase(p); }
    grid.sync();
    const XcdBarrier bar = xcd_barrier_post(ctl, MISC + 8);
#pragma unroll 1
    for (int l = 0; l < DEPTH; ++l) {
        { const PCP p = getp(); pg8::Gemm g; g.A = p->hb; g.Bt = p->win_t + (size_t)l * PP * DM; g.M = NTOK; g.N = PP; g.K = DM;
          pg8::EpiBf16<0> E; E.O = p->proj; E.ldc = PP; E.bias = nullptr; E.split_cols = 0; E.split_stride = 0; E.scale0 = 1.f;
          pg8::StaticOrder S; S.init(NTOK, PP, G, bid);
          pg8::gemm_phase<pg8::EpiBf16<0>, pg8::StaticOrder, true, true>((PG8_LAS unsigned char*)lds, g, S, E); }
        GRID_SYNC();
        for (int it = bid; it < 256; it += G) mixA_item(getp(), l, it, (float*)lds);
        for (int it = bid; it < 640; it += G) mixB_item(getp(), l, it, (float*)lds);
        for (int it = bid; it < 512; it += G) mixC_item(getp(), l, it, (float*)lds);
        for (int it = bid; it < 256; it += G) ssd_local_item(getp(), l, it, (lptr)lds);
        for (int it = bid; it < 256; it += G) mixD_sample_item(getp(), l, it, (float*)lds);
        GRID_SYNC();
        scan_phase(getp(), l);
        GRID_SYNC();
        for (int it = bid; it < 256; it += G) ssd_finish_item(getp(), l, it, (lptr)lds);
        GRID_SYNC();
        { const PCP p = getp(); pg8::Gemm g; g.A = p->mix; g.Bt = p->wout_t + (size_t)l * DM * DM; g.M = NTOK; g.N = DM; g.K = DM;
          pg8::EpiF32 E; E.C = p->mixed; E.ldc = DM; E.bias = nullptr;
          pg8::StaticOrder S; S.init(NTOK, DM, G, bid);
          pg8::gemm_phase<pg8::EpiF32, pg8::StaticOrder, true, true>((PG8_LAS unsigned char*)lds, g, S, E); }
        GRID_SYNC();
        post_phase(getp(), l);
        if (l + 1 < DEPTH) GRID_SYNC();
    }
}

extern "C" void kernel_launch(void* const* d_in, const int* in_sizes, int n_in, void* d_out, int out_size, void* d_ws, size_t ws_size, hipStream_t stream) {
    static int grid = 0;
    if (grid == 0) {
        if (n_in != 28 || in_sizes[0] != NP * DM || (size_t)out_size != O_END || ws_size < WS_END) {
            fprintf(stderr, "kernel_launch: unexpected shapes: n_in %d in0 %d out %d (want %zu) ws %zu (want >= %zu)\n", n_in, n_in > 0 ? in_sizes[0] : -1, out_size, (size_t)O_END, ws_size, (size_t)WS_END);
            grid = -1; return; }
        int dev = 0, cus = 0, per_cu = 0;
        if (hipGetDevice(&dev) != hipSuccess || hipDeviceGetAttribute(&cus, hipDeviceAttributeMultiprocessorCount, dev) != hipSuccess) { fprintf(stderr, "kernel_launch: device query failed\n"); grid = -1; return; }
        if (hipFuncSetAttribute((const void*)mega, hipFuncAttributeMaxDynamicSharedMemorySize, LDS_BYTES) != hipSuccess) { fprintf(stderr, "kernel_launch: hipFuncSetAttribute failed\n"); grid = -1; return; }
        if (hipOccupancyMaxActiveBlocksPerMultiprocessor(&per_cu, (const void*)mega, 512, LDS_BYTES) != hipSuccess || per_cu < 1) { fprintf(stderr, "kernel_launch: occupancy query says %d blocks/CU\n", per_cu); grid = -1; return; }
        (void)hipGetLastError();
        grid = cus;
    }
    if (grid < 0) return;
    unsigned char* ws = (unsigned char*)d_ws;
    P p; memset(&p, 0, sizeof p);
    const float** f = (const float**)&p;
    for (int i = 0; i < 28; ++i) f[i] = (const float*)d_in[i];
    p.out = (float*)d_out;
    p.win_t = (bf16*)(ws + WS_WIN); p.wout_t = (bf16*)(ws + WS_WOUT); p.hb = (bf16*)(ws + WS_HB); p.mix = (bf16*)(ws + WS_MIX); p.proj = (bf16*)(ws + WS_PROJ);
    p.mixed = (float*)(ws + WS_MIXED); p.yd = (float*)(ws + WS_YD); p.states = (float*)(ws + WS_ST); p.acum = (float*)(ws + WS_AC); p.cdec = (float*)(ws + WS_CD); p.ctl = (unsigned*)(ws + WS_CTL); p.cs = (bf16*)(ws + WS_CS);
    void* args[] = {&p};
    const hipError_t e = hipLaunchCooperativeKernel((const void*)mega, dim3(grid), dim3(512), args, LDS_BYTES, stream);
    if (e != hipSuccess) fprintf(stderr, "kernel_launch: cooperative launch failed: %s (grid %d)\n", hipGetErrorString(e), grid);
}
```

```cpp
#include <hip/hip_runtime.h>
#include <cstdio>
#include <cstdint>
#include <cstring>
#include <hip/hip_cooperative_groups.h>
namespace cg = cooperative_groups;
namespace pg8 {
#define PG8_LAS __attribute__((address_space(3)))
typedef unsigned short bf16_t;
typedef short bf16x8 __attribute__((ext_vector_type(8)));
typedef float f32x4 __attribute__((ext_vector_type(4)));
typedef unsigned u32x4 __attribute__((ext_vector_type(4)));
constexpr int BM = 256, BK = 64, HALF = 128, HTB = HALF * BK * 2  , STAGE_BYTES = 8 * HTB, NXCD = 8, WGM = 8;

__host__ __device__ __forceinline__ int lds_byte(int r, int c) { const int st = (r >> 4) * 2 + (c >> 5), rr = r & 15, cc = c & 31, ob = rr * 64 + cc * 2; return st * 1024 + (ob ^ (((ob >> 9) & 1) << 5)); }
__host__ __device__ __forceinline__ void stage_rc(int b, int& R, int& C) { const int st = b / 1024, sb = b % 1024, swz = sb ^ (((sb >> 9) & 1) << 5); R = (st >> 1) * 16 + swz / 64; C = (st & 1) * 32 + (swz % 64) / 2; }
__host__ __device__ __forceinline__ int perm32(int rho) { const int n = rho >> 4, i = rho & 15; return 8 * (i >> 2) + 4 * n + (i & 3); }

struct Unit { int pm, pn; };
struct Gemm { const bf16_t* A; const bf16_t* Bt; int M, N, K; };

struct StaticOrder {
    int nM, nN, nwg, G, c;
    __host__ __device__ void init(int M, int N, int G_, int c_) { nM = M / BM; nN = N / BM; nwg = nM * nN; G = G_; c = c_; }
    __host__ __device__ bool next(int i, Unit& u) const {
        const long L = (long)i * G + c; if (L >= nwg) return false;
        int wgid = (int)L; { const int q = nwg / NXCD, r = nwg % NXCD, xcd = wgid % NXCD, off = wgid / NXCD; wgid = (xcd < r ? xcd * (q + 1) : r * (q + 1) + (xcd - r) * q) + off; }
        const int nig = WGM * nN, gid = wgid / nig, fm = gid * WGM, gsz = (nM - fm) < WGM ? (nM - fm) : WGM;
        u.pm = fm + ((wgid % nig) % gsz); u.pn = (wgid % nig) / gsz; return true;
    }
    __device__ __forceinline__ void a_ready(const Unit&) const {}
    __device__ __forceinline__ void done(const Unit&) const {}
};

__device__ __forceinline__ unsigned cvt_pk_bf16(float lo, float hi) { unsigned r; asm volatile("v_cvt_pk_bf16_f32 %0, %1, %2" : "=v"(r) : "v"(lo), "v"(hi)); return r; }
typedef float f32x2 __attribute__((ext_vector_type(2)));
__device__ __forceinline__ f32x2 gelu_pk(f32x2 v) {
    const f32x2 av = __builtin_elementwise_abs(v), d = av * 0.2316418882f + 1.0f;
    f32x2 t; t.x = __builtin_amdgcn_rcpf(d.x); t.y = __builtin_amdgcn_rcpf(d.y);
    f32x2 q = t * 0.5307027145f + (-0.7265760135f); q = q * t + 0.7107068705f; q = q * t + (-0.142248368f); q = q * t + 0.127414796f; q = q * t;
    const f32x2 s = (v * v) * (-0.72134752044f);
    f32x2 e; e.x = __builtin_amdgcn_exp2f(s.x); e.y = __builtin_amdgcn_exp2f(s.y);
    const f32x2 m = v * (q * e), r = v - m;
    f32x2 o; o.x = v.x < 0.f ? m.x : r.x; o.y = v.y < 0.f ? m.y : r.y; return o;
}

struct EpiF32 {
    static constexpr bool PERM = false, AFTER_DRAIN = false;
    float* C; int ldc; const float* bias;
    __device__ __forceinline__ void operator()(const f32x4 (&acc)[2][2][4][2], const Unit& u, int wr, int wc, int fr, int fq) const {
        const int row0 = u.pm * BM + wr * 64 + fr, col0 = u.pn * BM + wc * 32 + 4 * fq;
        f32x4 bv[2][2];
#pragma unroll
        for (int bj = 0; bj < 2; ++bj)
#pragma unroll
            for (int n = 0; n < 2; ++n) bv[bj][n] = bias ? *(const f32x4*)(bias + col0 + bj * HALF + n * 16) : (f32x4){0.f, 0.f, 0.f, 0.f};
#pragma unroll
        for (int ai = 0; ai < 2; ++ai)
#pragma unroll
            for (int m = 0; m < 4; ++m) { float* rowp = C + (size_t)(row0 + ai * HALF + m * 16) * ldc + col0;
#pragma unroll
                for (int bj = 0; bj < 2; ++bj)
#pragma unroll
                    for (int n = 0; n < 2; ++n) *(f32x4*)(rowp + bj * HALF + n * 16) = acc[ai][bj][m][n] + bv[bj][n]; }
    }
};
template <int ACT  > struct EpiBf16 {
    static constexpr bool PERM = true, AFTER_DRAIN = false; static_assert(ACT == 0 || ACT == 1, "EpiBf16: ACT is 0 (none) or 1 (gelu_pk)");
    bf16_t* O; int ldc; const float* bias; int split_cols; size_t split_stride; float scale0;
    __device__ __forceinline__ void operator()(const f32x4 (&acc)[2][2][4][2], const Unit& u, int wr, int wc, int fr, int fq) const {
        const int row0 = u.pm * BM + wr * 64 + fr; int colt = u.pn * BM; bf16_t* base = O;
        float sc = 1.f; if (split_cols) { const int t = colt / split_cols; base += (size_t)t * split_stride; colt -= t * split_cols; if (t == 0) sc = scale0; }
        const int col0 = colt + wc * 32 + 8 * fq, bcol0 = u.pn * BM + wc * 32 + 8 * fq;
        f32x4 bv[2][2];
#pragma unroll
        for (int bj = 0; bj < 2; ++bj)
#pragma unroll
            for (int n = 0; n < 2; ++n) bv[bj][n] = bias ? *(const f32x4*)(bias + bcol0 + bj * HALF + 4 * n) : (f32x4){0.f, 0.f, 0.f, 0.f};
#pragma unroll
        for (int ai = 0; ai < 2; ++ai)
#pragma unroll
            for (int m = 0; m < 4; ++m) { bf16_t* rowp = base + (size_t)(row0 + ai * HALF + m * 16) * ldc + col0;
#pragma unroll
                for (int bj = 0; bj < 2; ++bj) { f32x4 v0 = acc[ai][bj][m][0] + bv[bj][0], v1 = acc[ai][bj][m][1] + bv[bj][1];
                    if (ACT == 1) { f32x2 a = gelu_pk((f32x2){v0[0], v0[1]}), b = gelu_pk((f32x2){v0[2], v0[3]}), c = gelu_pk((f32x2){v1[0], v1[1]}), d = gelu_pk((f32x2){v1[2], v1[3]});
                        v0 = (f32x4){a.x, a.y, b.x, b.y}; v1 = (f32x4){c.x, c.y, d.x, d.y}; }
                    v0 = v0 * sc; v1 = v1 * sc; u32x4 w; w.x = cvt_pk_bf16(v0[0], v0[1]); w.y = cvt_pk_bf16(v0[2], v0[3]); w.z = cvt_pk_bf16(v1[0], v1[1]); w.w = cvt_pk_bf16(v1[2], v1[3]);
                    *(u32x4*)(rowp + bj * HALF) = w; } }
    }
};

struct PanelStats {
    unsigned* xbuf;
    unsigned* cnt;
    unsigned* tmo;
    int ntn; float eps;
    unsigned code;
    __device__ __forceinline__ bool run(const f32x4 (&v)[2][2][4][2], const Unit& u, int wr, int wc, int fr, int fq, PG8_LAS unsigned char* lds, int wid, int lane) const {
        typedef float f32x2v __attribute__((ext_vector_type(2)));
        PG8_LAS f32x2v* P = (PG8_LAS f32x2v*)lds;
        PG8_LAS f32x2v* S = (PG8_LAS f32x2v*)(lds + 8192);
        PG8_LAS unsigned* flag = (PG8_LAS unsigned*)(lds + 8192 + 2048);
#pragma unroll
        for (int ai = 0; ai < 2; ++ai)
#pragma unroll
            for (int m = 0; m < 4; ++m) {
                float s = 0.f;
#pragma unroll
                for (int bj = 0; bj < 2; ++bj)
#pragma unroll
                    for (int n = 0; n < 2; ++n) { const f32x4 x = v[ai][bj][m][n]; s += (x[0] + x[1]) + (x[2] + x[3]); }
                s += __shfl_xor(s, 16); s += __shfl_xor(s, 32);
                const float mw = s * (1.0f / 64.0f); float q = 0.f;
#pragma unroll
                for (int bj = 0; bj < 2; ++bj)
#pragma unroll
                    for (int n = 0; n < 2; ++n) { const f32x4 d = v[ai][bj][m][n] - mw; q += (d[0] * d[0] + d[1] * d[1]) + (d[2] * d[2] + d[3] * d[3]); }
                q += __shfl_xor(q, 16); q += __shfl_xor(q, 32);
                if (fq == 0) P[(ai * HALF + wr * 64 + m * 16 + fr) * 4 + wc] = (f32x2v){mw, q};
            }
        asm volatile("s_waitcnt lgkmcnt(0)" ::: "memory"); __builtin_amdgcn_s_barrier(); asm volatile("" ::: "memory");
#if defined(BROKEN_EXCHANGE_NO_WAIT)
#warning BROKEN CONTROL BUILD: the row-statistics exchange does not wait; results are wrong by design
        if (blockIdx.x >= 64) { const long long t0_ = clock64(); while (clock64() - t0_ < 60000) __builtin_amdgcn_s_sleep(8); }
#endif
        const int row = wid * 32 + (lane & 31);
        if (lane < 32) {
            const f32x2v a = P[row * 4 + 0], b = P[row * 4 + 1], c = P[row * 4 + 2], d = P[row * 4 + 3];
            const float mt = (a.x + b.x + c.x + d.x) * 0.25f;
            const float da = a.x - mt, db = b.x - mt, dc = c.x - mt, dd = d.x - mt;
            const float m2 = (a.y + b.y) + (c.y + d.y) + 64.0f * ((da * da + db * db) + (dc * dc + dd * dd));
            unsigned long long* slot = (unsigned long long*)xbuf + ((size_t)(u.pm * BM + row) * 4 + u.pn);
            __hip_atomic_store(slot, ((unsigned long long)__float_as_uint(m2) << 32) | __float_as_uint(mt), __ATOMIC_RELAXED, __HIP_MEMORY_SCOPE_AGENT);
        }
        asm volatile("s_waitcnt vmcnt(0)" ::: "memory");
        if (lane == 0) __hip_atomic_fetch_add(cnt + 64 * u.pm, 1u, __ATOMIC_RELAXED, __HIP_MEMORY_SCOPE_AGENT);
        if (wid == 0) {
            bool dead = false; const unsigned long long t0 = __builtin_amdgcn_s_memrealtime(); const unsigned want = 8u * (unsigned)ntn;
            for (;;) {
#if defined(BROKEN_EXCHANGE_NO_WAIT)
                break;
#endif
                if ((unsigned)__builtin_amdgcn_readfirstlane(__hip_atomic_load(cnt + 64 * u.pm, __ATOMIC_RELAXED, __HIP_MEMORY_SCOPE_AGENT)) >= want) break;
                if (__builtin_amdgcn_s_memrealtime() - t0 > 2000000ull) {
                    if (lane == 0) { unsigned expect = 0u; __hip_atomic_compare_exchange_strong(tmo + 1, &expect, code | (unsigned)(u.pm & 0xff), __ATOMIC_RELAXED, __ATOMIC_RELAXED, __HIP_MEMORY_SCOPE_AGENT);
                                     __hip_atomic_store(tmo, 1u, __ATOMIC_RELAXED, __HIP_MEMORY_SCOPE_AGENT); }
                    dead = true; break; }
                __builtin_amdgcn_s_sleep(2);
            }
            __builtin_amdgcn_fence(__ATOMIC_ACQUIRE, "agent");
            if (lane == 0) flag[0] = dead ? 1u : 0u;
        }
        asm volatile("s_waitcnt vmcnt(0) lgkmcnt(0)" ::: "memory"); __builtin_amdgcn_s_barrier(); asm volatile("" ::: "memory");
        const bool bad = flag[0] != 0u;
        if (lane < 32) {
            const unsigned long long* slot = (const unsigned long long*)xbuf + (size_t)(u.pm * BM + row) * 4; float mt[4], m2[4]; float ms = 0.f;
#pragma unroll
            for (int t = 0; t < 4; ++t) { if (t < ntn) { const unsigned long long w = __hip_atomic_load(slot + t, __ATOMIC_RELAXED, __HIP_MEMORY_SCOPE_AGENT); mt[t] = __uint_as_float((unsigned)w); m2[t] = __uint_as_float((unsigned)(w >> 32)); } else { mt[t] = 0.f; m2[t] = 0.f; } ms += mt[t]; }
            const float mean = ms / (float)ntn; float q = 0.f;
#pragma unroll
            for (int t = 0; t < 4; ++t) if (t < ntn) { const float dm = mt[t] - mean; q += m2[t] + 256.0f * dm * dm; }
            S[row] = (f32x2v){mean, 1.0f / sqrtf(q / (256.0f * (float)ntn) + eps)};
        }
        asm volatile("s_waitcnt lgkmcnt(0)" ::: "memory"); __builtin_amdgcn_s_barrier(); asm volatile("" ::: "memory");
        return bad;
    }
};
struct EpiLnRes {
    static constexpr bool PERM = false, AFTER_DRAIN = true;
    const float* base; float* out; int ldc; const float* bias; PanelStats st; unsigned poison;
    __device__ __forceinline__ void fused(f32x4 (&acc)[2][2][4][2], const Unit& u, int wr, int wc, int fr, int fq, PG8_LAS unsigned char* lds, int wid, int lane) const {
        typedef float f32x2v __attribute__((ext_vector_type(2)));
        const PG8_LAS f32x2v* S = (const PG8_LAS f32x2v*)(lds + 8192);
        const int col0 = u.pn * BM + wc * 32 + 4 * fq;
#pragma unroll
        for (int bj = 0; bj < 2; ++bj)
#pragma unroll
            for (int n = 0; n < 2; ++n) { const f32x4 bv = bias ? *(const f32x4*)(bias + col0 + bj * HALF + n * 16) : (f32x4){0.f, 0.f, 0.f, 0.f};
#pragma unroll
                for (int ai = 0; ai < 2; ++ai)
#pragma unroll
                    for (int m = 0; m < 4; ++m) acc[ai][bj][m][n] += bv; }
        f32x4 pre[4][2][2];
#pragma unroll
        for (int m = 0; m < 4; ++m) { const size_t off = (size_t)(u.pm * BM + wr * 64 + m * 16 + fr) * ldc + col0;
#pragma unroll
            for (int bj = 0; bj < 2; ++bj)
#pragma unroll
                for (int n = 0; n < 2; ++n) pre[m][bj][n] = *(const f32x4*)(base + off + bj * HALF + n * 16); }
        const bool bad = st.run(acc, u, wr, wc, fr, fq, lds, wid, lane) || poison != 0u;
        const float qnan = __builtin_nanf("");
#pragma unroll
        for (int ai = 0; ai < 2; ++ai)
#pragma unroll
            for (int m = 0; m < 4; ++m) { const int r = ai * HALF + wr * 64 + m * 16 + fr; const f32x2v sr = S[r]; const size_t off = (size_t)(u.pm * BM + r) * ldc + col0;
#pragma unroll
                for (int bj = 0; bj < 2; ++bj)
#pragma unroll
                    for (int n = 0; n < 2; ++n) { const f32x4 bs = ai == 0 ? pre[m][bj][n] : *(const f32x4*)(base + off + bj * HALF + n * 16); f32x4 o = bs + (acc[ai][bj][m][n] - sr.x) * sr.y;
                        if (bad) o = (f32x4){qnan, qnan, qnan, qnan}; *(f32x4*)(out + off + bj * HALF + n * 16) = o; }
                if (m & 1) asm volatile("" ::: "memory"); }
    }
};
struct EpiLnResLn {
    static constexpr bool PERM = false, AFTER_DRAIN = true;
    const float* base; float* out; bf16_t* xn; int ldc; const float* bias; PanelStats st1, st2; unsigned poison;
    __device__ __forceinline__ void fused(f32x4 (&acc)[2][2][4][2], const Unit& u, int wr, int wc, int fr, int fq, PG8_LAS unsigned char* lds, int wid, int lane) const {
        typedef float f32x2v __attribute__((ext_vector_type(2))); typedef unsigned u32x2v __attribute__((ext_vector_type(2)));
        const PG8_LAS f32x2v* S = (const PG8_LAS f32x2v*)(lds + 8192);
        const int col0 = u.pn * BM + wc * 32 + 4 * fq;
#pragma unroll
        for (int bj = 0; bj < 2; ++bj)
#pragma unroll
            for (int n = 0; n < 2; ++n) { const f32x4 bv = bias ? *(const f32x4*)(bias + col0 + bj * HALF + n * 16) : (f32x4){0.f, 0.f, 0.f, 0.f};
#pragma unroll
                for (int ai = 0; ai < 2; ++ai)
#pragma unroll
                    for (int m = 0; m < 4; ++m) acc[ai][bj][m][n] += bv; }
        bool bad = st1.run(acc, u, wr, wc, fr, fq, lds, wid, lane) || poison != 0u;
        const float qnan = __builtin_nanf("");
#pragma unroll
        for (int ai = 0; ai < 2; ++ai)
#pragma unroll
            for (int m = 0; m < 4; ++m) { const int r = ai * HALF + wr * 64 + m * 16 + fr; const f32x2v sr = S[r]; const size_t off = (size_t)(u.pm * BM + r) * ldc + col0;
#pragma unroll
                for (int bj = 0; bj < 2; ++bj)
#pragma unroll
                    for (int n = 0; n < 2; ++n) { const f32x4 bs = *(const f32x4*)(base + off + bj * HALF + n * 16); acc[ai][bj][m][n] = bs + (acc[ai][bj][m][n] - sr.x) * sr.y; }
                asm volatile("" : "+v"(acc[ai][0][m][0]), "+v"(acc[ai][0][m][1]), "+v"(acc[ai][1][m][0]), "+v"(acc[ai][1][m][1]));
                if (m & 1) asm volatile("" ::: "memory"); }
        const bool bad1 = bad;
        bad = st2.run(acc, u, wr, wc, fr, fq, lds, wid, lane) || bad;
#pragma unroll
        for (int ai = 0; ai < 2; ++ai)
#pragma unroll
            for (int m = 0; m < 4; ++m) { const int r = ai * HALF + wr * 64 + m * 16 + fr; const f32x2v sr = S[r]; const size_t off = (size_t)(u.pm * BM + r) * ldc + col0;
#pragma unroll
                for (int bj = 0; bj < 2; ++bj)
#pragma unroll
                    for (int n = 0; n < 2; ++n) { const f32x4 x1 = acc[ai][bj][m][n]; *(f32x4*)(out + off + bj * HALF + n * 16) = bad1 ? (f32x4){qnan, qnan, qnan, qnan} : x1;
                        const f32x4 o = (x1 - sr.x) * sr.y; u32x2v w; w.x = cvt_pk_bf16(o[0], o[1]); w.y = cvt_pk_bf16(o[2], o[3]);
                        if (bad) { w.x = 0x7fc07fc0u; w.y = 0x7fc07fc0u; } *(u32x2v*)(xn + off + bj * HALF + n * 16) = w; }
                asm volatile("" ::: "memory"); }
    }
};

template <class Epi, class Sched, bool ALIGN_EPI = false, bool SP2 = false>
__device__ __forceinline__ void gemm_phase(PG8_LAS unsigned char* lds, const Gemm g, const Sched& S, const Epi& E) {
    const int tid = threadIdx.x, wid = __builtin_amdgcn_readfirstlane(tid >> 6), lane = tid & 63, wr = wid >> 2, wc = wid & 3, fr = lane & 15, fq = lane >> 4;
    const int K = g.K, nt = K / BK;
    unsigned voffA[2], voffB[2];
#pragma unroll
    for (int i = 0; i < 2; ++i) { int R, C; stage_rc(tid * 16 + i * 8192, R, C); const int Rb = Epi::PERM ? ((R & ~31) + perm32(R & 31)) : R;
        voffA[i] = (unsigned)(R * K + C) * 2u; voffB[i] = (unsigned)(Rb * K + C) * 2u; }
    const size_t kstep = (size_t)(BK * 2);
    const size_t hstep = (size_t)HALF * K * 2;
    const size_t tstep = 2 * hstep;
    const unsigned ldsw = (unsigned)wid * 1024u;
    const int aoff = lds_byte(wr * 64 + fr, fq * 8), boff = lds_byte(wc * 32 + fr, fq * 8);
#define PG8_SA(b, h) (((b) * 2 + (h)) * HTB)
#define PG8_SB(b, h) ((4 + (b) * 2 + (h)) * HTB)
#define PG8_STAGE(bufoff, gbase, voff) do { _Pragma("unroll") for (int _i = 0; _i < 2; ++_i) \
        __builtin_amdgcn_global_load_lds((const unsigned*)((const char*)(gbase) + (voff)[_i]), (PG8_LAS unsigned*)(lds + (bufoff) + ldsw + _i * 8192), 16, 0, 0); } while (0)
#define PG8_LDA(dst, b, h) do { _Pragma("unroll") for (int m = 0; m < 4; ++m) _Pragma("unroll") for (int k = 0; k < 2; ++k) dst[m][k] = *(const PG8_LAS bf16x8*)(lds + PG8_SA(b, h) + aoff + m * 2048 + k * 1024); } while (0)
#define PG8_LDB(dst, b, h) do { _Pragma("unroll") for (int n = 0; n < 2; ++n) _Pragma("unroll") for (int k = 0; k < 2; ++k) dst[n][k] = *(const PG8_LAS bf16x8*)(lds + PG8_SB(b, h) + boff + n * 2048 + k * 1024); } while (0)
#define PG8_MMA(ai, bj, At, Bt) do { __builtin_amdgcn_s_setprio(1); _Pragma("unroll") for (int m = 0; m < 4; ++m) _Pragma("unroll") for (int n = 0; n < 2; ++n) _Pragma("unroll") for (int k = 0; k < 2; ++k) \
        acc[ai][bj][m][n] = __builtin_amdgcn_mfma_f32_16x16x32_bf16(Bt[n][k], At[m][k], acc[ai][bj][m][n], 0, 0, 0); __builtin_amdgcn_s_setprio(0); } while (0)
#define PG8_WAIT_V(n) asm volatile("s_waitcnt vmcnt(" #n ")" ::: "memory")
#define PG8_WAIT_L(n) asm volatile("s_waitcnt lgkmcnt(" #n ")" ::: "memory")
#define PG8_BAR __builtin_amdgcn_s_barrier()
#define PG8_SCHED __builtin_amdgcn_sched_barrier(0)
    Unit cur, nxt; int ui = 0;
    if (!S.next(0, cur)) return;
    f32x4 acc[2][2][4][2];
#pragma unroll
    for (int a = 0; a < 2; ++a)
#pragma unroll
        for (int b = 0; b < 2; ++b)
#pragma unroll
            for (int m = 0; m < 4; ++m)
#pragma unroll
                for (int n = 0; n < 2; ++n) acc[a][b][m][n] = (f32x4){0.f, 0.f, 0.f, 0.f};
    bf16x8 At[4][2], B0[2][2], B1[2][2];
    const char* cA = (const char*)g.A + (size_t)cur.pm * tstep; const char* cB = (const char*)g.Bt + (size_t)cur.pn * tstep;
    S.a_ready(cur);
    if constexpr (SP2) {
        PG8_STAGE(PG8_SB(0, 0), cB, voffB); PG8_STAGE(PG8_SB(0, 1), cB + hstep, voffB); PG8_STAGE(PG8_SA(0, 0), cA, voffA); PG8_STAGE(PG8_SA(0, 1), cA + hstep, voffA);
        if (wr == 1) PG8_BAR;
        PG8_WAIT_V(2); PG8_BAR;
        PG8_STAGE(PG8_SB(1, 0), cB + kstep, voffB); PG8_STAGE(PG8_SA(1, 0), cA + kstep, voffA); PG8_STAGE(PG8_SB(1, 1), cB + hstep + kstep, voffB);
        PG8_WAIT_V(6); PG8_BAR;
    } else {
        PG8_STAGE(PG8_SB(0, 0), cB, voffB); PG8_STAGE(PG8_SA(0, 0), cA, voffA); PG8_STAGE(PG8_SB(0, 1), cB + hstep, voffB); PG8_STAGE(PG8_SA(0, 1), cA + hstep, voffA);
        if (wr == 1) PG8_BAR;
        PG8_WAIT_V(4); PG8_BAR;
        PG8_STAGE(PG8_SB(1, 0), cB + kstep, voffB); PG8_STAGE(PG8_SA(1, 0), cA + kstep, voffA); PG8_STAGE(PG8_SB(1, 1), cB + hstep + kstep, voffB);
        PG8_WAIT_V(6); PG8_BAR;
    }
    for (;;) {
        const bool has_next = S.next(ui + 1, nxt);
        const char* nA = has_next ? (const char*)g.A + (size_t)nxt.pm * tstep : cA; const char* nB = has_next ? (const char*)g.Bt + (size_t)nxt.pn * tstep : cB;
        for (int t = 0; t < nt; t += 2) {
            const bool last = (t == nt - 2);
            const char* a1 = cA + (size_t)(t + 1) * kstep;
            const char* a2 = last ? nA : cA + (size_t)(t + 2) * kstep; const char* b2 = last ? nB : cB + (size_t)(t + 2) * kstep;
            const char* a3 = a2 + kstep; const char* b3 = b2 + kstep;
            if (last && has_next) S.a_ready(nxt);
            if constexpr (SP2) {
            PG8_LDB(B0, 0, 0); PG8_LDB(B1, 0, 1); PG8_SCHED; PG8_LDA(At, 0, 0); PG8_STAGE(PG8_SA(1, 1), a1 + hstep, voffA);
            PG8_WAIT_V(8); PG8_WAIT_L(0); PG8_BAR; PG8_MMA(0, 0, At, B0); PG8_MMA(0, 1, At, B1); PG8_BAR; PG8_SCHED;
            PG8_LDA(At, 0, 1); PG8_STAGE(PG8_SB(0, 0), b2, voffB); PG8_STAGE(PG8_SB(0, 1), b2 + hstep, voffB); PG8_STAGE(PG8_SA(0, 0), a2, voffA);
            PG8_WAIT_V(8); PG8_WAIT_L(0); PG8_BAR; PG8_MMA(1, 0, At, B0); PG8_MMA(1, 1, At, B1); PG8_BAR; PG8_SCHED;
            PG8_LDB(B0, 1, 0); PG8_LDB(B1, 1, 1); PG8_SCHED; PG8_LDA(At, 1, 0); PG8_STAGE(PG8_SA(0, 1), a2 + hstep, voffA);
            PG8_WAIT_V(8); PG8_WAIT_L(0); PG8_BAR; PG8_MMA(0, 0, At, B0); PG8_MMA(0, 1, At, B1); PG8_BAR; PG8_SCHED;
            PG8_LDA(At, 1, 1); PG8_STAGE(PG8_SB(1, 0), b3, voffB); PG8_STAGE(PG8_SB(1, 1), b3 + hstep, voffB); PG8_STAGE(PG8_SA(1, 0), a3, voffA);
            PG8_WAIT_V(8); PG8_WAIT_L(0); PG8_BAR; PG8_MMA(1, 0, At, B0); PG8_MMA(1, 1, At, B1); PG8_BAR; PG8_SCHED;
            } else {
            PG8_LDB(B0, 0, 0); PG8_SCHED; PG8_LDA(At, 0, 0); PG8_STAGE(PG8_SA(1, 1), a1 + hstep, voffA);
            PG8_WAIT_L(8); PG8_BAR; PG8_WAIT_L(0); PG8_MMA(0, 0, At, B0); PG8_BAR; PG8_SCHED;
            PG8_LDB(B1, 0, 1); PG8_STAGE(PG8_SB(0, 0), b2, voffB);
            PG8_BAR; PG8_WAIT_L(0); PG8_MMA(0, 1, At, B1); PG8_BAR;
            PG8_LDA(At, 0, 1); PG8_STAGE(PG8_SA(0, 0), a2, voffA);
            PG8_BAR; PG8_WAIT_L(0); PG8_MMA(1, 0, At, B0); PG8_BAR; PG8_SCHED;
            PG8_STAGE(PG8_SB(0, 1), b2 + hstep, voffB);
            PG8_WAIT_V(6); PG8_BAR; PG8_MMA(1, 1, At, B1); PG8_BAR;
            PG8_LDB(B0, 1, 0); PG8_SCHED; PG8_LDA(At, 1, 0); PG8_STAGE(PG8_SA(0, 1), a2 + hstep, voffA);
            PG8_WAIT_L(8); PG8_BAR; PG8_WAIT_L(0); PG8_MMA(0, 0, At, B0); PG8_BAR; PG8_SCHED;
            PG8_LDB(B1, 1, 1); PG8_STAGE(PG8_SB(1, 0), b3, voffB);
            PG8_BAR; PG8_WAIT_L(0); PG8_MMA(0, 1, At, B1); PG8_BAR;
            PG8_LDA(At, 1, 1); PG8_STAGE(PG8_SA(1, 0), a3, voffA);
            PG8_BAR; PG8_WAIT_L(0); PG8_MMA(1, 0, At, B0); PG8_BAR; PG8_SCHED;
            PG8_STAGE(PG8_SB(1, 1), b3 + hstep, voffB);
            PG8_WAIT_V(6); PG8_BAR; PG8_MMA(1, 1, At, B1); PG8_BAR;
            }
        }
        if constexpr (ALIGN_EPI) { if (wr == 0) PG8_BAR; }
        if constexpr (!Epi::AFTER_DRAIN) { E(acc, cur, wr, wc, fr, fq); S.done(cur); }
        if (!has_next) break;
#pragma unroll
        for (int a = 0; a < 2; ++a)
#pragma unroll
            for (int b = 0; b < 2; ++b)
#pragma unroll
                for (int m = 0; m < 4; ++m)
#pragma unroll
                    for (int n = 0; n < 2; ++n) acc[a][b][m][n] = (f32x4){0.f, 0.f, 0.f, 0.f};
        cur = nxt; cA = nA; cB = nB; ++ui;
        if constexpr (ALIGN_EPI) { if (wr == 1) PG8_BAR; }
    }
    PG8_WAIT_V(0);
    if constexpr (!ALIGN_EPI) { if (wr == 0) PG8_BAR; }
    PG8_BAR;
    if constexpr (Epi::AFTER_DRAIN) { E.fused(acc, cur, wr, wc, fr, fq, lds, wid, lane); S.done(cur); }
#undef PG8_SA
#undef PG8_SB
#undef PG8_STAGE
#undef PG8_LDA
#undef PG8_LDB
#undef PG8_MMA
#undef PG8_WAIT_V
#undef PG8_WAIT_L
#undef PG8_BAR
#undef PG8_SCHED
}
}

typedef unsigned short bf16;
constexpr int DM = 1024, SEQ = 8192, NB = 2, DEPTH = 4, SB = 128, SL = 8;
constexpr int NP = NB * SEQ;
constexpr int NS = SB * SL;
constexpr int NTOK = NP + NS;
constexpr int IN_DIM = 3332, PP = 3584;
constexpr int AU = 0, AV = 256, AZ = 512, BV = 768, BG = 1024, BZ = 1280, CQ = 1536, CK = 1792, CV = 1920, CZ = 2048, DZ = 2304, DX = 2560, DT = 3328;
constexpr float EPS = 1e-6f;
constexpr size_t O_YP = 0, O_YS = O_YP + (size_t)NP * DM, O_KP = O_YS + (size_t)NS * DM, O_KS = O_KP + 4 * 2 * 128 * 128, O_VP = O_KS + 4 * 128 * 8 * 128,
                 O_VS = O_VP + 4 * 2 * 128 * 128, O_CBP = O_VS + 4 * 128 * 8 * 128, O_CBS = O_CBP + 4 * 2 * 30 * 256, O_CDP = O_CBS + 4 * 128 * 8 * 256,
                 O_CDS = O_CDP + 4 * 2 * 3 * 768, O_SSP = O_CDS + (size_t)4 * 128 * 8 * 768, O_SSS = O_SSP + 4 * 2 * 4 * 64 * 128, O_AV = O_SSS + (size_t)4 * 128 * 4 * 64 * 128,
                 O_END = O_AV + 4 * 128 * 8 * 256;
constexpr size_t MiB = 1u << 20;
constexpr size_t WS_CTL = 0, WS_WIN = 2 * MiB, WS_WOUT = 30 * MiB, WS_PW = 38 * MiB, WS_HB = 40 * MiB, WS_MIX = 74 * MiB, WS_PROJ = 108 * MiB, WS_MIXED = WS_PROJ,
                 WS_YD = 227 * MiB, WS_ST = 243 * MiB, WS_AC = 259 * MiB, WS_CD = WS_AC + 512 * 1024, WS_CS = 260 * MiB, WS_END = 268 * MiB;
static_assert(WS_WIN + (size_t)DEPTH * PP * DM * 2 <= WS_WOUT && WS_HB + (size_t)NTOK * DM * 2 <= WS_MIX && WS_MIX + (size_t)NTOK * DM * 2 <= WS_PROJ &&
              WS_PROJ + (size_t)NTOK * PP * 2 <= WS_YD && WS_MIXED + (size_t)NTOK * DM * 4 <= WS_YD, "ws map");

struct P {
    const float *x_prompt, *x_sample, *cache_k, *cache_v, *st_conv_b, *st_conv_d, *st_ssm, *norm_pre, *norm_post, *w_in, *w_out, *a_ln_g, *a_ln_b, *a_ws, *a_wb,
        *b_conv_w, *b_conv_b, *b_ln_g, *b_ln_b, *b_pw_w, *b_pw_b, *c_sinks, *d_conv_w, *d_conv_b, *d_dt_bias, *d_a_log, *d_skip, *d_norm_g;
    float* out;
    bf16 *win_t, *wout_t, *hb, *mix, *proj, *cs, *pwt, *wpt, *wsb;
    float *mixed, *yd, *states, *acum, *cdec;
    unsigned* ctl;
    int layer, pad;
};

typedef const P __attribute__((address_space(4)))* PCP;
__device__ __forceinline__ PCP getp() { PCP q = (PCP)__builtin_amdgcn_kernarg_segment_ptr(); asm volatile("" : "+s"(q)); return q; }
__device__ __forceinline__ float bf2f(bf16 v) { return __uint_as_float((unsigned)v << 16); }
__device__ __forceinline__ bf16 f2bf(float f) { unsigned u = __float_as_uint(f); return (bf16)((u + 0x7fffu + ((u >> 16) & 1u)) >> 16); }
__device__ __forceinline__ float sigmoid_(float x) { return 1.f / (1.f + __expf(-x)); }
__device__ __forceinline__ float silu_(float x) { return x / (1.f + __expf(-x)); }
__device__ __forceinline__ float gelu_(float x) { const float u = 0.7978845608028654f * (x + 0.044715f * x * x * x); return x / (1.f + __expf(-2.f * u)); }
__device__ __forceinline__ float softplus_(float x) { return x > 20.f ? x : log1pf(__expf(x)); }
__device__ __forceinline__ int tid_() { int t = threadIdx.x; asm volatile("" : "+v"(t)); return t; }
__device__ __forceinline__ float wave_sum(float v) {
#pragma unroll
    for (int o = 1; o < 64; o <<= 1) v += __shfl_xor(v, o);
    return v;
}


#define LAS __attribute__((address_space(3)))
typedef short bf16x8 __attribute__((ext_vector_type(8)));
typedef short s16x4 __attribute__((ext_vector_type(4)));
typedef float f32x4 __attribute__((ext_vector_type(4)));
typedef LAS unsigned char* lptr;
typedef unsigned u32x4 __attribute__((ext_vector_type(4)));
typedef unsigned u32x2 __attribute__((ext_vector_type(2)));
#define MFMA16(a, b, c) __builtin_amdgcn_mfma_f32_16x16x32_bf16((a), (b), (c), 0, 0, 0)
__device__ __forceinline__ bf16x8 frag_row(lptr base, int ldb, int r0, int k0, int lane) { return *(const LAS bf16x8*)(base + (r0 + (lane & 15)) * ldb + (k0 + 8 * (lane >> 4)) * 2); }
__device__ __forceinline__ s16x4 tr16(lptr a) { return __builtin_bit_cast(s16x4, __builtin_amdgcn_ds_read_tr16_b64_v4i16((LAS s16x4*)a)); }
__device__ __forceinline__ bf16x8 frag_tr(lptr base, int ldb, int k0, int j0, int lane) {
    const int i = lane & 15; lptr a = base + (k0 + 8 * (lane >> 4) + (i >> 2)) * ldb + (j0 + 4 * (i & 3)) * 2;
    const s16x4 lo = tr16(a), hi = tr16(a + 4 * ldb);
    return __builtin_shufflevector(lo, hi, 0, 1, 2, 3, 4, 5, 6, 7);
}
__device__ __forceinline__ unsigned pk2(float lo, float hi) { return (unsigned)f2bf(lo) | ((unsigned)f2bf(hi) << 16); }
__device__ __forceinline__ void unpack8(const u32x4 v, float (&f)[8]) {
    f[0] = __uint_as_float(v.x << 16); f[1] = __uint_as_float(v.x & 0xffff0000u); f[2] = __uint_as_float(v.y << 16); f[3] = __uint_as_float(v.y & 0xffff0000u);
    f[4] = __uint_as_float(v.z << 16); f[5] = __uint_as_float(v.z & 0xffff0000u); f[6] = __uint_as_float(v.w << 16); f[7] = __uint_as_float(v.w & 0xffff0000u);
}
__device__ __forceinline__ u32x4 pack8(const float (&f)[8]) { u32x4 o; o.x = pk2(f[0], f[1]); o.y = pk2(f[2], f[3]); o.z = pk2(f[4], f[5]); o.w = pk2(f[6], f[7]); return o; }

__device__ __forceinline__ void norm0_phase(const PCP p) {
    const int tid = tid_(), lane = tid & 63, gw = blockIdx.x * 8 + (tid >> 6), ngw = gridDim.x * 8;
    for (int r = gw; r < NTOK; r += ngw) {
        const float* src = r < NP ? p->x_prompt + (size_t)r * DM : p->x_sample + (size_t)(r - NP) * DM;
        float4 v[4]; float ss = 0.f;
#pragma unroll
        for (int j = 0; j < 4; ++j) { v[j] = ((const float4*)src)[lane + 64 * j]; ss += v[j].x * v[j].x + v[j].y * v[j].y + v[j].z * v[j].z + v[j].w * v[j].w; }
        const float rstd = rsqrtf(wave_sum(ss) * (1.f / DM) + EPS);
#pragma unroll
        for (int j = 0; j < 4; ++j) {
            ((float4*)(p->out + (size_t)r * DM))[lane + 64 * j] = v[j];
            const float4 g = ((const float4*)p->norm_pre)[lane + 64 * j];
            ushort4 o; o.x = f2bf(v[j].x * rstd * g.x); o.y = f2bf(v[j].y * rstd * g.y); o.z = f2bf(v[j].z * rstd * g.z); o.w = f2bf(v[j].w * rstd * g.w);
            ((ushort4*)(p->hb + (size_t)r * DM))[lane + 64 * j] = o;
        }
    }
}
__device__ __forceinline__ void post_phase(const PCP p, const int l) {
    const int tid = tid_(), lane = tid & 63, gw = blockIdx.x * 8 + (tid >> 6), ngw = gridDim.x * 8;
    for (int r = gw; r < NTOK; r += ngw) {
        float4 m[4], x[4]; float ss = 0.f;
#pragma unroll
        for (int j = 0; j < 4; ++j) { m[j] = ((const float4*)(p->mixed + (size_t)r * DM))[lane + 64 * j]; ss += m[j].x * m[j].x + m[j].y * m[j].y + m[j].z * m[j].z + m[j].w * m[j].w; }
        const float rstd = rsqrtf(wave_sum(ss) * (1.f / DM) + EPS);
        float sx = 0.f;
#pragma unroll
        for (int j = 0; j < 4; ++j) {
            x[j] = ((const float4*)(p->out + (size_t)r * DM))[lane + 64 * j];
            const float4 g = ((const float4*)(p->norm_post + l * DM))[lane + 64 * j];
            x[j].x += m[j].x * rstd * g.x; x[j].y += m[j].y * rstd * g.y; x[j].z += m[j].z * rstd * g.z; x[j].w += m[j].w * rstd * g.w;
            sx += x[j].x * x[j].x + x[j].y * x[j].y + x[j].z * x[j].z + x[j].w * x[j].w;
            ((float4*)(p->out + (size_t)r * DM))[lane + 64 * j] = x[j];
        }
        if (l + 1 < DEPTH) {
            const float rx = rsqrtf(wave_sum(sx) * (1.f / DM) + EPS);
#pragma unroll
            for (int j = 0; j < 4; ++j) {
                const float4 g = ((const float4*)(p->norm_pre + (l + 1) * DM))[lane + 64 * j];
                ushort4 o; o.x = f2bf(x[j].x * rx * g.x); o.y = f2bf(x[j].y * rx * g.y); o.z = f2bf(x[j].z * rx * g.z); o.w = f2bf(x[j].w * rx * g.w);
                ((ushort4*)(p->hb + (size_t)r * DM))[lane + 64 * j] = o;
            }
        }
    }
}


__device__ __forceinline__ void mixA_item(const PCP p, const int l, int item, float* lds) {
    const int tid = tid_(), lane = tid & 63, wave = tid >> 6;
    const bool sample = item >= 128;
    const int q = sample ? 8 : 128, row0 = sample ? NP + (item - 128) * 8 : item * 128;
    const float* lng = p->a_ln_g + l * 256; const float* lnb = p->a_ln_b + l * 256;
    for (int t = wave; t < q; t += 8) {
        const bf16* pr = p->proj + (size_t)(row0 + t) * PP + AV + lane * 4;
        const ushort4 raw = *(const ushort4*)pr;
        float g[4] = {gelu_(bf2f(raw.x)), gelu_(bf2f(raw.y)), gelu_(bf2f(raw.z)), gelu_(bf2f(raw.w))};
        const float mean = wave_sum(g[0] + g[1] + g[2] + g[3]) * (1.f / 256.f);
        float d2 = 0.f;
#pragma unroll
        for (int k = 0; k < 4; ++k) { g[k] -= mean; d2 += g[k] * g[k]; }
        const float rstd = rsqrtf(wave_sum(d2) * (1.f / 256.f) + EPS);
#pragma unroll
        for (int k = 0; k < 4; ++k) {
            const float v = g[k] * rstd * lng[lane * 4 + k] + lnb[lane * 4 + k];
            lds[t * 256 + lane * 4 + k] = v;
            if (sample) p->out[O_AV + ((size_t)(l * 128 + (item - 128)) * 8 + t) * 256 + lane * 4 + k] = v;
        }
    }
    __syncthreads();
    const int c = tid & 255, th = tid >> 8, h = c >> 6;
    const float* W = p->a_ws + (size_t)(l * 4 + h) * 128 * 128; const float* wb = p->a_wb + (l * 4 + h) * 128;
    for (int t = th; t < q; t += 2) {
        float acc = 0.f; const float* wr = W + t * 128;
        for (int s = 0; s <= t; ++s) acc += wr[s] * lds[s * 256 + c];
        acc += wb[t];
        const bf16* pr = p->proj + (size_t)(row0 + t) * PP;
        const float u = gelu_(bf2f(pr[AU + c])), z = bf2f(pr[AZ + c]);
        p->mix[(size_t)(row0 + t) * DM + c] = f2bf(u * acc * silu_(z));
    }
    __syncthreads();
}

__device__ __forceinline__ void mixB_item(const PCP p, const int l, int item, float* lds) {
    const int tid = tid_(), lane = tid & 63, wave = tid >> 6;
    float* glu = lds; float* cln = lds + 62 * 256;
    const bool sample = item >= 512;
    const int nt = sample ? 8 : 32, b = sample ? 0 : item >> 8, t0 = sample ? 0 : (item & 255) * 32, n = item - 512;
    const int row0 = sample ? NP + n * 8 : b * SEQ + t0;
    for (int j = wave; j < nt + 30; j += 8) {
        float g[4] = {0.f, 0.f, 0.f, 0.f};
        int srow = -1;
        if (!sample) { const int t = t0 - 30 + j; if (t >= 0) srow = b * SEQ + t; }
        else { if (j >= 30) srow = row0 + j - 30; else { const float4 s4 = *(const float4*)(p->st_conv_b + ((size_t)(l * 128 + n) * 30 + j) * 256 + lane * 4); g[0] = s4.x; g[1] = s4.y; g[2] = s4.z; g[3] = s4.w; } }
        if (srow >= 0) {
            const ushort4 v = *(const ushort4*)(p->proj + (size_t)srow * PP + BV + lane * 4);
            const ushort4 gg = *(const ushort4*)(p->proj + (size_t)srow * PP + BG + lane * 4);
            g[0] = bf2f(v.x) * sigmoid_(bf2f(gg.x)); g[1] = bf2f(v.y) * sigmoid_(bf2f(gg.y)); g[2] = bf2f(v.z) * sigmoid_(bf2f(gg.z)); g[3] = bf2f(v.w) * sigmoid_(bf2f(gg.w));
        }
#pragma unroll
        for (int k = 0; k < 4; ++k) glu[j * 256 + lane * 4 + k] = g[k];
        if (sample && j >= 30) *(float4*)(p->out + O_CBS + ((size_t)(l * 128 + n) * 8 + (j - 30)) * 256 + lane * 4) = make_float4(g[0], g[1], g[2], g[3]);
        if (!sample) { const int t = t0 - 30 + j; if (t >= SEQ - 30) *(float4*)(p->out + O_CBP + ((size_t)(l * 2 + b) * 30 + (t - (SEQ - 30))) * 256 + lane * 4) = make_float4(g[0], g[1], g[2], g[3]); }
    }
    __syncthreads();
    for (int t = wave; t < nt; t += 8) {
        float c[4];
#pragma unroll
        for (int k = 0; k < 4; ++k) c[k] = p->b_conv_b[l * 256 + lane * 4 + k];
#pragma unroll 1
        for (int j = 0; j < 31; ++j) {
            const float4 w = *(const float4*)(p->b_conv_w + (size_t)(l * 31 + j) * 256 + lane * 4);
            const float* gr = glu + (t + j) * 256 + lane * 4;
            c[0] += w.x * gr[0]; c[1] += w.y * gr[1]; c[2] += w.z * gr[2]; c[3] += w.w * gr[3];
        }
        const float mean = wave_sum(c[0] + c[1] + c[2] + c[3]) * (1.f / 256.f);
        float d2 = 0.f;
#pragma unroll
        for (int k = 0; k < 4; ++k) { c[k] -= mean; d2 += c[k] * c[k]; }
        const float rstd = rsqrtf(wave_sum(d2) * (1.f / 256.f) + EPS);
#pragma unroll
        for (int k = 0; k < 4; ++k) cln[t * 256 + lane * 4 + k] = silu_(c[k] * rstd * p->b_ln_g[l * 256 + lane * 4 + k] + p->b_ln_b[l * 256 + lane * 4 + k]);
    }
    __syncthreads();
    const int co = tid & 255, th = tid >> 8, half = nt >> 1, tb = th * half;
    float acc[16];
#pragma unroll
    for (int i = 0; i < 16; ++i) acc[i] = 0.f;
    const float* pw = p->b_pw_w + (size_t)l * 256 * 256 + co;
#pragma unroll 2
    for (int ci = 0; ci < 256; ++ci) {
        const float w = pw[(size_t)ci * 256];
#pragma unroll
        for (int i = 0; i < 16; ++i) if (i < half) acc[i] += cln[(tb + i) * 256 + ci] * w;
    }
    const float pb = p->b_pw_b[l * 256 + co];
#pragma unroll
    for (int i = 0; i < 16; ++i) if (i < half) {
        const size_t row = (size_t)(row0 + tb + i);
        const float z = bf2f(p->proj[row * PP + BZ + co]);
        p->mix[row * DM + 256 + co] = f2bf((acc[i] + pb) * silu_(z));
    }
    __syncthreads();
}

__device__ __forceinline__ void mixC_item(const PCP p, const int l, int item, float* lds) {
    const int tid = tid_();
    float* Ks = lds; float* Vs = lds + 256 * 65;
    const bool sample = item >= 256;
    const int kh = item & 1, b = item >> 7, qb = (item >> 1) & 63, n = (item - 256) >> 1;
    if (!sample) {
        for (int idx = tid; idx < 256 * 64; idx += 512) {
            const int j = idx >> 6, d = idx & 63, pos = (qb - 1) * 128 + j;
            float kv = 0.f, vv = 0.f;
            if (pos >= 0) { const size_t row = (size_t)b * SEQ + pos; kv = bf2f(p->proj[row * PP + CK + kh * 64 + d]); vv = bf2f(p->proj[row * PP + CV + kh * 64 + d]); }
            Ks[j * 65 + d] = kv; Vs[j * 65 + d] = vv;
            if (qb == 63 && j >= 128) { const size_t o = (((size_t)(l * 2 + b) * 128 + (j - 128)) * 2 + kh) * 64 + d; p->out[O_KP + o] = kv; p->out[O_VP + o] = vv; }
        }
    } else {
        for (int idx = tid; idx < 136 * 64; idx += 512) {
            const int j = idx >> 6, d = idx & 63;
            float kv, vv;
            if (j < 128) { const size_t o = ((((size_t)l * 128 + n) * 128 + j) * 2 + kh) * 64 + d; kv = p->cache_k[o]; vv = p->cache_v[o]; }
            else { const size_t row = (size_t)NP + n * 8 + (j - 128); kv = bf2f(p->proj[row * PP + CK + kh * 64 + d]); vv = bf2f(p->proj[row * PP + CV + kh * 64 + d]);
                   const size_t o = (((size_t)(l * 128 + n) * 8 + (j - 128)) * 2 + kh) * 64 + d; p->out[O_KS + o] = kv; p->out[O_VS + o] = vv; }
            Ks[j * 65 + d] = kv; Vs[j * 65 + d] = vv;
        }
    }
    __syncthreads();
    const int nq = sample ? 8 : 128;
    if (tid < 2 * nq) {
        const int qi = tid % nq, g = tid / nq, h = kh * 2 + g;
        const size_t row = sample ? (size_t)NP + n * 8 + qi : (size_t)b * SEQ + qb * 128 + qi;
        float qv[64], o[64];
#pragma unroll
        for (int d = 0; d < 64; ++d) { qv[d] = bf2f(p->proj[row * PP + CQ + h * 64 + d]) * 0.125f; o[d] = 0.f; }
        const float slope = exp2f(-2.f * (float)(h + 1));
        float m = p->c_sinks[l * 4 + h], lsum = 1.f;
        for (int j = qi; j <= qi + 128; ++j) {
            if (!sample && (qb - 1) * 128 + j < 0) continue;
            float s = 0.f;
#pragma unroll
            for (int d = 0; d < 64; ++d) s += qv[d] * Ks[j * 65 + d];
            s -= slope * (float)(qi + 128 - j);
            const float mn = fmaxf(m, s), sc = __expf(m - mn), pe = __expf(s - mn);
            lsum = lsum * sc + pe;
#pragma unroll
            for (int d = 0; d < 64; ++d) o[d] = o[d] * sc + pe * Vs[j * 65 + d];
            m = mn;
        }
        const float inv = 1.f / lsum;
#pragma unroll
        for (int d = 0; d < 64; ++d) {
            const float z = bf2f(p->proj[row * PP + CZ + h * 64 + d]);
            p->mix[row * DM + 512 + h * 64 + d] = f2bf(o[d] * inv * silu_(z));
        }
    }
    __syncthreads();
}

__device__ __forceinline__ void mixD_local_item(const PCP p, const int l, int item, unsigned char* ldsb) {
    const int tid = tid_();
    bf16* Xs = (bf16*)ldsb; bf16* Bs = Xs + 128 * 128; bf16* Cs = Bs + 128 * 128; bf16* Ss = Cs + 128 * 128;
    float* dts = (float*)(Ss + 128 * 128); float* acs = dts + 256; float* wts = acs + 256;
    const int cidx = item >> 1, g = item & 1, b = cidx >> 6, c = cidx & 63, t0 = c * 128; const size_t row0 = (size_t)b * SEQ + t0;
    for (int idx = tid; idx < 128 * 384; idx += 512) {
        const int t = idx / 384, cc = idx % 384, part = cc >> 7, col = cc & 127, xcol = part * 256 + g * 128 + col;
        float acc = p->d_conv_b[l * 768 + xcol];
#pragma unroll
        for (int j = 0; j < 4; ++j) { const int tt = t0 + t - 3 + j; if (tt >= 0) acc += p->d_conv_w[(l * 4 + j) * 768 + xcol] * bf2f(p->proj[((size_t)b * SEQ + tt) * PP + DX + xcol]); }
        const bf16 v = f2bf(silu_(acc));
        (part == 0 ? Xs : part == 1 ? Bs : Cs)[t * 128 + col] = v;
        if (c == 63 && t >= 125) p->out[O_CDP + ((size_t)(l * 2 + b) * 3 + (t - 125)) * 768 + xcol] = bf2f(p->proj[(row0 + t) * PP + DX + xcol]);
    }
    if (tid < 256) { const int h2 = tid >> 7, t = tid & 127, h = 2 * g + h2; dts[h2 * 128 + t] = softplus_(bf2f(p->proj[(row0 + t) * PP + DT + h]) + p->d_dt_bias[l * 4 + h]); }
    __syncthreads();
    if (tid < 2) { const int h = 2 * g + tid; const float a = -__expf(p->d_a_log[l * 4 + h]); float s = 0.f; for (int t = 0; t < 128; ++t) { s += dts[tid * 128 + t] * a; acs[tid * 128 + t] = s; } }
    __syncthreads();
    if (tid < 256) { const int h2 = tid >> 7, t = tid & 127, h = 2 * g + h2; p->acum[(row0 + t) * 4 + h] = acs[h2 * 128 + t]; }
    float gv[32];
    { const int t = tid >> 2;
#pragma unroll
      for (int i = 0; i < 32; ++i) { const int s = (tid & 3) + 4 * i; float acc = 0.f; if (s <= t) {
#pragma unroll 4
          for (int nn = 0; nn < 128; ++nn) acc += bf2f(Cs[t * 128 + nn]) * bf2f(Bs[s * 128 + nn]); } gv[i] = acc; } }
    for (int h2 = 0; h2 < 2; ++h2) {
        const int h = 2 * g + h2; const float aclast = acs[h2 * 128 + 127];
        { const int t = tid >> 2;
#pragma unroll
          for (int i = 0; i < 32; ++i) { const int s = (tid & 3) + 4 * i; Ss[t * 128 + s] = f2bf(s <= t ? gv[i] * __expf(acs[h2 * 128 + t] - acs[h2 * 128 + s]) * dts[h2 * 128 + s] : 0.f); } }
        if (tid < 128) wts[tid] = __expf(aclast - acs[h2 * 128 + tid]) * dts[h2 * 128 + tid];
        __syncthreads();
        { const int pcol = tid & 63, tq = tid >> 6; const float dsk = p->d_skip[l * 4 + h];
#pragma unroll 1
          for (int i = 0; i < 16; ++i) { const int t2 = tq + 8 * i; float acc = 0.f;
#pragma unroll 4
              for (int s = 0; s <= t2; ++s) acc += bf2f(Ss[t2 * 128 + s]) * bf2f(Xs[s * 128 + h2 * 64 + pcol]);
              acc += dsk * bf2f(Xs[t2 * 128 + h2 * 64 + pcol]);
              p->yd[(row0 + t2) * 256 + h * 64 + pcol] = acc; } }
        { const int nn = tid & 127, pq = tid >> 7;
#pragma unroll 1
          for (int i = 0; i < 16; ++i) { const int pp = pq + 4 * i; float acc = 0.f;
#pragma unroll 4
              for (int s = 0; s < 128; ++s) acc += wts[s] * bf2f(Xs[s * 128 + h2 * 64 + pp]) * bf2f(Bs[s * 128 + nn]);
              p->states[((size_t)(cidx * 4 + h) * 64 + pp) * 128 + nn] = acc; } }
        if (tid == 0) p->cdec[cidx * 4 + h] = __expf(aclast);
        __syncthreads();
    }
}
__device__ __forceinline__ void scan_phase(const PCP p, const int l) {
    for (int e = blockIdx.x * 512 + tid_(); e < NB * 4 * 64 * 128; e += gridDim.x * 512) {
        const int b = e >> 15, h = (e >> 13) & 3, pn = e & 8191;
        float hp = 0.f;
        for (int c = 0; c < 64; ++c) { const size_t o = ((size_t)((b * 64 + c) * 4 + h)) * 8192 + pn; const float st = p->states[o]; p->states[o] = hp; hp = hp * p->cdec[(b * 64 + c) * 4 + h] + st; }
        p->out[O_SSP + ((size_t)(l * 2 + b) * 4 + h) * 8192 + pn] = hp;
    }
}
__device__ __forceinline__ void mixD_finish_item(const PCP p, const int l, int item, unsigned char* ldsb) {
    const int tid = tid_(), lane = tid & 63, wave = tid >> 6;
    bf16* Cs = (bf16*)ldsb; float* Hin = (float*)(ldsb + 128 * 128 * 2);
    const int cidx = item >> 1, g = item & 1, b = cidx >> 6, c = cidx & 63, t0 = c * 128; const size_t row0 = (size_t)b * SEQ + t0;
    for (int idx = tid; idx < 128 * 128; idx += 512) {
        const int t = idx >> 7, col = idx & 127, xcol = 512 + g * 128 + col;
        float acc = p->d_conv_b[l * 768 + xcol];
#pragma unroll
        for (int j = 0; j < 4; ++j) { const int tt = t0 + t - 3 + j; if (tt >= 0) acc += p->d_conv_w[(l * 4 + j) * 768 + xcol] * bf2f(p->proj[((size_t)b * SEQ + tt) * PP + DX + xcol]); }
        Cs[t * 128 + col] = f2bf(silu_(acc));
    }
    for (int idx = tid; idx < 128 * 128; idx += 512) { const int hp = idx >> 7, nn = idx & 127; Hin[hp * 129 + nn] = p->states[((size_t)(cidx * 4 + 2 * g + (hp >> 6)) * 64 + (hp & 63)) * 128 + nn]; }
    __syncthreads();
    for (int t = wave; t < 128; t += 8) {
        float y[2]; float ss = 0.f;
#pragma unroll
        for (int k = 0; k < 2; ++k) {
            const int hp = lane + 64 * k, h = 2 * g + k;
            float acc = 0.f;
            for (int nn = 0; nn < 128; ++nn) acc += bf2f(Cs[t * 128 + nn]) * Hin[hp * 129 + nn];
            float v = p->yd[(row0 + t) * 256 + g * 128 + hp] + __expf(p->acum[(row0 + t) * 4 + h]) * acc;
            v *= silu_(bf2f(p->proj[(row0 + t) * PP + DZ + g * 128 + hp]));
            y[k] = v; ss += v * v;
        }
        const float rstd = rsqrtf(wave_sum(ss) * (1.f / 128.f) + EPS);
#pragma unroll
        for (int k = 0; k < 2; ++k) { const int hp = lane + 64 * k; p->mix[(row0 + t) * DM + 768 + g * 128 + hp] = f2bf(y[k] * rstd * p->d_norm_g[l * 256 + g * 128 + hp]); }
    }
    __syncthreads();
}
__device__ __forceinline__ void mixD_sample_item(const PCP p, const int l, int item, float* lds) {
    const int tid = tid_(), lane = tid & 63, wave = tid >> 6;
    float* X8 = lds; float* B8 = X8 + 8 * 128; float* C8 = B8 + 8 * 128; float* Y8 = C8 + 8 * 128; float* dt8 = Y8 + 8 * 128;
    const int n = item >> 1, g = item & 1; const size_t row0 = (size_t)NP + n * 8;
    for (int idx = tid; idx < 8 * 384; idx += 512) {
        const int t = idx / 384, cc = idx % 384, part = cc >> 7, col = cc & 127, xcol = part * 256 + g * 128 + col;
        float acc = p->d_conv_b[l * 768 + xcol];
#pragma unroll
        for (int j = 0; j < 4; ++j) { const int tt = t - 3 + j;
            const float xv = tt >= 0 ? bf2f(p->proj[(row0 + tt) * PP + DX + xcol]) : p->st_conv_d[((size_t)(l * 128 + n) * 3 + (tt + 3)) * 768 + xcol];
            acc += p->d_conv_w[(l * 4 + j) * 768 + xcol] * xv; }
        (part == 0 ? X8 : part == 1 ? B8 : C8)[t * 128 + col] = bf2f(f2bf(silu_(acc)));
        p->out[O_CDS + ((size_t)(l * 128 + n) * 8 + t) * 768 + xcol] = bf2f(p->proj[(row0 + t) * PP + DX + xcol]);
    }
    if (tid < 16) { const int h2 = tid >> 3, t = tid & 7, h = 2 * g + h2; dt8[h2 * 8 + t] = softplus_(bf2f(p->proj[(row0 + t) * PP + DT + h]) + p->d_dt_bias[l * 4 + h]); }
    __syncthreads();
    const int h2 = tid >> 8, pp = (tid >> 2) & 63, nr = (tid & 3) * 32, h = 2 * g + h2;
    const float a = -__expf(p->d_a_log[l * 4 + h]), dsk = p->d_skip[l * 4 + h];
    float hs[32];
    const size_t so = (((size_t)(l * 128 + n) * 4 + h) * 64 + pp) * 128 + nr;
#pragma unroll
    for (int k = 0; k < 32; k += 4) { const float4 v = *(const float4*)(p->st_ssm + so + k); hs[k] = v.x; hs[k + 1] = v.y; hs[k + 2] = v.z; hs[k + 3] = v.w; }
    for (int t = 0; t < 8; ++t) {
        const float dt = dt8[h2 * 8 + t], dA = __expf(dt * a), xv = X8[t * 128 + h2 * 64 + pp] * dt;
        float part = 0.f;
#pragma unroll
        for (int k = 0; k < 32; ++k) { hs[k] = hs[k] * dA + xv * B8[t * 128 + nr + k]; part += C8[t * 128 + nr + k] * hs[k]; }
        part += __shfl_xor(part, 1); part += __shfl_xor(part, 2);
        if ((tid & 3) == 0) Y8[t * 128 + h2 * 64 + pp] = part + dsk * X8[t * 128 + h2 * 64 + pp];
    }
#pragma unroll
    for (int k = 0; k < 32; k += 4) *(float4*)(p->out + O_SSS + so + k) = make_float4(hs[k], hs[k + 1], hs[k + 2], hs[k + 3]);
    __syncthreads();
    { const int t = wave; float y[2]; float ss = 0.f;
#pragma unroll
      for (int k = 0; k < 2; ++k) { const int hp = lane + 64 * k; float v = Y8[t * 128 + hp] * silu_(bf2f(p->proj[(row0 + t) * PP + DZ + g * 128 + hp])); y[k] = v; ss += v * v; }
      const float rstd = rsqrtf(wave_sum(ss) * (1.f / 128.f) + EPS);
#pragma unroll
      for (int k = 0; k < 2; ++k) { const int hp = lane + 64 * k; p->mix[(row0 + t) * DM + 768 + g * 128 + hp] = f2bf(y[k] * rstd * p->d_norm_g[l * 256 + g * 128 + hp]); } }
    __syncthreads();
}


constexpr int LD_D = 272, R_C = 0, R_B = 128 * LD_D, R_X = 2 * 128 * LD_D, R_W = 3 * 128 * LD_D, SM_D = 4 * 128 * LD_D;
__device__ __forceinline__ void ssd_local_item(const PCP p, const int l, int item, lptr lds) {
    const int tid = tid_(), lane = tid & 63, wave = __builtin_amdgcn_readfirstlane(tid >> 6);
    LAS float* dts = (LAS float*)(lds + SM_D); LAS float* acs = dts + 256; LAS float* wts = acs + 256;
    const int cidx = item >> 1, g = item & 1, b = cidx >> 6, c = cidx & 63, t0 = c * 128; const size_t row0 = (size_t)b * SEQ + t0;
    if (tid < 384) {
        const int cg = tid % 48, rl = tid / 48, part = cg >> 4, col = (cg & 15) * 8, xcol = part * 256 + g * 128 + col;
        float w[4][8], bias[8];
#pragma unroll
        for (int j = 0; j < 4; ++j) { const float4 a = *(const float4*)(p->d_conv_w + (size_t)(l * 4 + j) * 768 + xcol), bq = *(const float4*)(p->d_conv_w + (size_t)(l * 4 + j) * 768 + xcol + 4);
            w[j][0] = a.x; w[j][1] = a.y; w[j][2] = a.z; w[j][3] = a.w; w[j][4] = bq.x; w[j][5] = bq.y; w[j][6] = bq.z; w[j][7] = bq.w; }
        { const float4 a = *(const float4*)(p->d_conv_b + l * 768 + xcol), bq = *(const float4*)(p->d_conv_b + l * 768 + xcol + 4);
          bias[0] = a.x; bias[1] = a.y; bias[2] = a.z; bias[3] = a.w; bias[4] = bq.x; bias[5] = bq.y; bias[6] = bq.z; bias[7] = bq.w; }
        const lptr dst = lds + (part == 0 ? R_X : part == 1 ? R_B : R_C) + col * 2;
        const bf16* src = p->proj + row0 * PP + DX + xcol;
#pragma unroll 1
        for (int k = 0; k < 4; ++k) {
            const int r4 = 4 * (rl + 8 * k);
            u32x4 raw[7];
#pragma unroll
            for (int j = 0; j < 7; ++j) { const int t = r4 - 3 + j; raw[j] = (t0 + t >= 0) ? *(const u32x4*)(src + (long)t * PP) : (u32x4){0u, 0u, 0u, 0u}; }
            float x[7][8];
#pragma unroll
            for (int j = 0; j < 7; ++j) unpack8(raw[j], x[j]);
#pragma unroll
            for (int r = 0; r < 4; ++r) {
                float o[8];
#pragma unroll
                for (int e = 0; e < 8; ++e) o[e] = silu_(bias[e] + w[0][e] * x[r][e] + w[1][e] * x[r + 1][e] + w[2][e] * x[r + 2][e] + w[3][e] * x[r + 3][e]);
                const u32x4 pk = pack8(o);
                *(LAS u32x4*)(dst + (r4 + r) * LD_D) = pk;
                if (part == 2) *(u32x4*)(p->cs + (row0 + r4 + r) * 256 + g * 128 + col) = pk;
            }
            if (c == 63 && r4 == 124) {
#pragma unroll
                for (int r = 1; r < 4; ++r) { float* o = p->out + O_CDP + ((size_t)(l * 2 + b) * 3 + (r - 1)) * 768 + xcol;
                    *(float4*)o = make_float4(x[r + 3][0], x[r + 3][1], x[r + 3][2], x[r + 3][3]); *(float4*)(o + 4) = make_float4(x[r + 3][4], x[r + 3][5], x[r + 3][6], x[r + 3][7]); }
            }
        }
    } else {
        const int t = tid - 384;
#pragma unroll
        for (int h2 = 0; h2 < 2; ++h2) { const int h = 2 * g + h2; dts[h2 * 128 + t] = softplus_(bf2f(p->proj[(row0 + t) * PP + DT + h]) + p->d_dt_bias[l * 4 + h]); }
    }
    __syncthreads();
    if (wave < 2) {
        const int h2 = wave, h = 2 * g + h2; const float a = -__expf(p->d_a_log[l * 4 + h]);
        const float d0 = dts[h2 * 128 + 2 * lane], d1 = dts[h2 * 128 + 2 * lane + 1];
        const float x0 = d0 * a, x1 = d1 * a; float tot = x0 + x1;
#pragma unroll
        for (int o = 1; o < 64; o <<= 1) { const float v = __shfl_up(tot, o); if (lane >= o) tot += v; }
        const float last = __shfl(tot, 63);
        const float a0 = tot - x1, a1 = tot;
        acs[h2 * 128 + 2 * lane] = a0; acs[h2 * 128 + 2 * lane + 1] = a1;
        wts[h2 * 128 + 2 * lane] = __expf(last - a0) * d0; wts[h2 * 128 + 2 * lane + 1] = __expf(last - a1) * d1;
        p->acum[(row0 + 2 * lane) * 4 + h] = a0; p->acum[(row0 + 2 * lane + 1) * 4 + h] = a1;
        if (lane == 0) p->cdec[cidx * 4 + h] = __expf(last);
    }
    __syncthreads();
    f32x4 gacc[5];
#pragma unroll
    for (int k = 0; k < 5; ++k) {
        gacc[k] = (f32x4){0.f, 0.f, 0.f, 0.f};
        int pi = wave + 8 * k;
        if (pi < 36) { int i = 0; while (pi > i) { pi -= i + 1; ++i; } const int j = pi;
#pragma unroll
            for (int ks = 0; ks < 4; ++ks) gacc[k] = MFMA16(frag_row(lds + R_B, LD_D, 16 * j, 32 * ks, lane), frag_row(lds + R_C, LD_D, 16 * i, 32 * ks, lane), gacc[k]); }
    }
#pragma unroll
    for (int k = 0; k < 4; ++k) { const int ch = tid + 512 * k, s = ch >> 4, cc = (ch & 15) * 8; float f[8]; unpack8(*(const LAS u32x4*)(lds + R_X + s * LD_D + cc * 2), f); const float ws_ = wts[(cc >> 6) * 128 + s];
#pragma unroll
        for (int e = 0; e < 8; ++e) f[e] *= ws_;
        *(LAS u32x4*)(lds + R_W + s * LD_D + cc * 2) = pack8(f); }
    __syncthreads();
#pragma unroll
    for (int h2 = 0; h2 < 2; ++h2) {
        const int h = 2 * g + h2;
#pragma unroll
        for (int k = 0; k < 5; ++k) {
            int pi = wave + 8 * k;
            if (pi < 36) { int i = 0; while (pi > i) { pi -= i + 1; ++i; } const int j = pi;
                const int t = 16 * i + (lane & 15), s0 = 16 * j + 4 * (lane >> 4);
                const float at = acs[h2 * 128 + t]; const f32x4 as4 = *(const LAS f32x4*)(acs + h2 * 128 + s0), dt4 = *(const LAS f32x4*)(dts + h2 * 128 + s0);
                float v[4];
#pragma unroll
                for (int r = 0; r < 4; ++r) v[r] = (s0 + r <= t) ? gacc[k][r] * __expf(at - as4[r]) * dt4[r] : 0.f;
                *(LAS u32x2*)(lds + R_C + t * LD_D + s0 * 2) = (u32x2){pk2(v[0], v[1]), pk2(v[2], v[3])};
                if (j == i && (i & 1) == 0) *(LAS u32x2*)(lds + R_C + t * LD_D + (s0 + 16) * 2) = (u32x2){0u, 0u};
            }
        }
        __syncthreads();
        { const float dsk = p->d_skip[l * 4 + h];
#pragma unroll
          for (int tt = 0; tt < 2; ++tt) {
              const int i = tt == 0 ? (wave >> 1) : 7 - (wave >> 1), nks = (i >> 1) + 1;
#pragma unroll
              for (int pq = 0; pq < 2; ++pq) {
                  const int pt = 2 * (wave & 1) + pq; f32x4 acc = (f32x4){0.f, 0.f, 0.f, 0.f};
                  for (int ks = 0; ks < nks; ++ks) acc = MFMA16(frag_tr(lds + R_X, LD_D, 32 * ks, h2 * 64 + 16 * pt, lane), frag_row(lds + R_C, LD_D, 16 * i, 32 * ks, lane), acc);
                  const int t = 16 * i + (lane & 15), pp = 16 * pt + 4 * (lane >> 4);
                  const u32x2 xr = *(const LAS u32x2*)(lds + R_X + t * LD_D + (h2 * 64 + pp) * 2);
                  float4 o; o.x = acc[0] + dsk * __uint_as_float(xr.x << 16); o.y = acc[1] + dsk * __uint_as_float(xr.x & 0xffff0000u); o.z = acc[2] + dsk * __uint_as_float(xr.y << 16); o.w = acc[3] + dsk * __uint_as_float(xr.y & 0xffff0000u);
                  *(float4*)(p->yd + (row0 + t) * 256 + h * 64 + pp) = o;
              }
          } }
        if (h2 == 0) {
            bf16x8 bt[4];
#pragma unroll
            for (int ks = 0; ks < 4; ++ks) bt[ks] = frag_tr(lds + R_B, LD_D, 32 * ks, 16 * wave, lane);
#pragma unroll
            for (int pt = 0; pt < 8; ++pt) {
                f32x4 acc = (f32x4){0.f, 0.f, 0.f, 0.f};
#pragma unroll
                for (int ks = 0; ks < 4; ++ks) acc = MFMA16(bt[ks], frag_tr(lds + R_W, LD_D, 32 * ks, 16 * pt, lane), acc);
                const int p2 = 16 * pt + (lane & 15), n0 = 16 * wave + 4 * (lane >> 4);
                *(float4*)(p->states + ((size_t)(cidx * 4 + 2 * g + (p2 >> 6)) * 64 + (p2 & 63)) * 128 + n0) = make_float4(acc[0], acc[1], acc[2], acc[3]);
            }
        }
        __syncthreads();
    }
}
__device__ __forceinline__ void ssd_finish_item(const PCP p, const int l, int item, lptr lds) {
    const int tid = tid_(), lane = tid & 63, wave = __builtin_amdgcn_readfirstlane(tid >> 6);
    const int cidx = item >> 1, g = item & 1, b = cidx >> 6, c = cidx & 63, t0 = c * 128; const size_t row0 = (size_t)b * SEQ + t0;
#pragma unroll
    for (int k = 0; k < 4; ++k) { const int ch = tid + 512 * k, r = ch >> 4, cc = (ch & 15) * 8;
        *(LAS u32x4*)(lds + R_C + r * LD_D + cc * 2) = *(const u32x4*)(p->cs + (row0 + r) * 256 + g * 128 + cc);
        const float* hp = p->states + ((size_t)(cidx * 4 + 2 * g + (r >> 6)) * 64 + (r & 63)) * 128 + cc;
        const float4 a = *(const float4*)hp, bq = *(const float4*)(hp + 4);
        *(LAS u32x4*)(lds + R_B + r * LD_D + cc * 2) = (u32x4){pk2(a.x, a.y), pk2(a.z, a.w), pk2(bq.x, bq.y), pk2(bq.z, bq.w)}; }
    __syncthreads();
    const int t = 16 * wave + (lane & 15); const size_t row = row0 + t;
    bf16x8 cf[4];
#pragma unroll
    for (int ks = 0; ks < 4; ++ks) cf[ks] = frag_row(lds + R_C, LD_D, 16 * wave, 32 * ks, lane);
    const float e0 = __expf(p->acum[row * 4 + 2 * g]), e1 = __expf(p->acum[row * 4 + 2 * g + 1]);
    float v[8][4]; float ss = 0.f;
#pragma unroll
    for (int pt = 0; pt < 8; ++pt) {
        f32x4 acc = (f32x4){0.f, 0.f, 0.f, 0.f};
#pragma unroll
        for (int ks = 0; ks < 4; ++ks) acc = MFMA16(frag_row(lds + R_B, LD_D, 16 * pt, 32 * ks, lane), cf[ks], acc);
        const int p2 = 16 * pt + 4 * (lane >> 4); const float ex = pt < 4 ? e0 : e1;
        const float4 y0 = *(const float4*)(p->yd + row * 256 + g * 128 + p2);
        const uint2 zr = *(const uint2*)(p->proj + row * PP + DZ + g * 128 + p2);
        v[pt][0] = (y0.x + ex * acc[0]) * silu_(__uint_as_float(zr.x << 16)); v[pt][1] = (y0.y + ex * acc[1]) * silu_(__uint_as_float(zr.x & 0xffff0000u));
        v[pt][2] = (y0.z + ex * acc[2]) * silu_(__uint_as_float(zr.y << 16)); v[pt][3] = (y0.w + ex * acc[3]) * silu_(__uint_as_float(zr.y & 0xffff0000u));
        ss += v[pt][0] * v[pt][0] + v[pt][1] * v[pt][1] + v[pt][2] * v[pt][2] + v[pt][3] * v[pt][3];
    }
    ss += __shfl_xor(ss, 16); ss += __shfl_xor(ss, 32);
    const float rstd = rsqrtf(ss * (1.f / 128.f) + EPS);
#pragma unroll
    for (int pt = 0; pt < 8; ++pt) { const int p2 = 16 * pt + 4 * (lane >> 4); const float4 ng = *(const float4*)(p->d_norm_g + l * 256 + g * 128 + p2);
        *(uint2*)(p->mix + row * DM + 768 + g * 128 + p2) = make_uint2(pk2(v[pt][0] * rstd * ng.x, v[pt][1] * rstd * ng.y), pk2(v[pt][2] * rstd * ng.z, v[pt][3] * rstd * ng.w)); }
    __syncthreads();
}

constexpr int LD_K = 144, LD_P = 336, A_K = 0, A_V = 256 * LD_K, A_P = A_V + 272 * LD_K, A_PW = 16 * LD_P;
__device__ __forceinline__ void attn_item(const PCP p, const int l, int item, lptr lds) {
    const int tid = tid_(), lane = tid & 63, wave = __builtin_amdgcn_readfirstlane(tid >> 6);
    const int kh = item & 1, b = item >> 7, qb = (item >> 1) & 63;
#pragma unroll
    for (int k = 0; k < 4; ++k) {
        const int ch = tid + 512 * k, j = ch >> 3, cc = (ch & 7) * 8, pos = (qb - 1) * 128 + j;
        u32x4 kv = (u32x4){0u, 0u, 0u, 0u}, vv = kv;
        if (pos >= 0) { const bf16* src = p->proj + ((size_t)b * SEQ + pos) * PP + kh * 64 + cc; kv = *(const u32x4*)(src + CK); vv = *(const u32x4*)(src + CV); }
        *(LAS u32x4*)(lds + A_K + j * LD_K + cc * 2) = kv; *(LAS u32x4*)(lds + A_V + j * LD_K + cc * 2) = vv;
        if (qb == 63 && j >= 128) { float f[8]; const size_t o = (((size_t)(l * 2 + b) * 128 + (j - 128)) * 2 + kh) * 64 + cc;
            unpack8(kv, f); *(float4*)(p->out + O_KP + o) = make_float4(f[0], f[1], f[2], f[3]); *(float4*)(p->out + O_KP + o + 4) = make_float4(f[4], f[5], f[6], f[7]);
            unpack8(vv, f); *(float4*)(p->out + O_VP + o) = make_float4(f[0], f[1], f[2], f[3]); *(float4*)(p->out + O_VP + o + 4) = make_float4(f[4], f[5], f[6], f[7]); }
    }
    if (tid < 128) *(LAS u32x4*)(lds + A_V + (256 + (tid >> 3)) * LD_K + (tid & 7) * 16) = (u32x4){0u, 0u, 0u, 0u};
    __syncthreads();
    const lptr Pw = lds + A_P + wave * A_PW;
    const int ql = lane & 15, lg = lane >> 4;
    const size_t row = (size_t)b * SEQ + qb * 128 + 16 * wave + ql;
#pragma unroll 1
    for (int g2 = 0; g2 < 2; ++g2) {
        const int h = 2 * kh + g2;
        const float slope = exp2f(-2.f * (float)(h + 1)), sink = p->c_sinks[l * 4 + h];
        bf16x8 qf[2];
#pragma unroll
        for (int ds = 0; ds < 2; ++ds) qf[ds] = *(const bf16x8*)(p->proj + row * PP + CQ + h * 64 + 32 * ds + 8 * lg);
        f32x4 sc[9];
#pragma unroll
        for (int kt = 0; kt < 9; ++kt) { sc[kt] = (f32x4){0.f, 0.f, 0.f, 0.f};
#pragma unroll
            for (int ds = 0; ds < 2; ++ds) sc[kt] = MFMA16(frag_row(lds + A_K, LD_K, 16 * wave + 16 * kt, 32 * ds, lane), qf[ds], sc[kt]); }
        float m = sink;
#pragma unroll
        for (int kt = 0; kt < 9; ++kt)
#pragma unroll
            for (int r = 0; r < 4; ++r) { const int rel = 128 + ql - 16 * kt - 4 * lg - r; const bool ok = rel >= 0 && rel <= 128 && (qb > 0 || 16 * wave + 16 * kt + 4 * lg + r >= 128);
                const float s = ok ? sc[kt][r] * 0.125f - slope * (float)rel : -INFINITY; sc[kt][r] = s; m = fmaxf(m, s); }
        m = fmaxf(m, __shfl_xor(m, 16)); m = fmaxf(m, __shfl_xor(m, 32));
        float ls = 0.f;
#pragma unroll
        for (int kt = 0; kt < 9; ++kt) { float e[4];
#pragma unroll
            for (int r = 0; r < 4; ++r) { e[r] = __expf(sc[kt][r] - m); ls += e[r]; }
            *(LAS u32x2*)(Pw + ql * LD_P + (16 * kt + 4 * lg) * 2) = (u32x2){pk2(e[0], e[1]), pk2(e[2], e[3])}; }
        *(LAS u32x2*)(Pw + ql * LD_P + (144 + 4 * lg) * 2) = (u32x2){0u, 0u};
        ls += __shfl_xor(ls, 16); ls += __shfl_xor(ls, 32);
        const float inv = 1.f / (ls + __expf(sink - m));
        asm volatile("s_waitcnt lgkmcnt(0)" ::: "memory");
        bf16x8 pf[5];
#pragma unroll
        for (int ks = 0; ks < 5; ++ks) pf[ks] = frag_row(Pw, LD_P, 0, 32 * ks, lane);
#pragma unroll
        for (int n = 0; n < 4; ++n) {
            f32x4 o = (f32x4){0.f, 0.f, 0.f, 0.f};
#pragma unroll
            for (int ks = 0; ks < 5; ++ks) o = MFMA16(frag_tr(lds + A_V, LD_K, 16 * wave + 32 * ks, 16 * n, lane), pf[ks], o);
            const int d0 = 16 * n + 4 * lg;
            const u32x2 zr = *(const u32x2*)(p->proj + row * PP + CZ + h * 64 + d0);
            *(u32x2*)(p->mix + row * DM + 512 + h * 64 + d0) = (u32x2){pk2(o[0] * inv * silu_(__uint_as_float(zr.x << 16)), o[1] * inv * silu_(__uint_as_float(zr.x & 0xffff0000u))),
                                                                       pk2(o[2] * inv * silu_(__uint_as_float(zr.y << 16)), o[3] * inv * silu_(__uint_as_float(zr.y & 0xffff0000u)))};
        }
        asm volatile("s_waitcnt lgkmcnt(0)" ::: "memory");
    }
    __syncthreads();
}

constexpr int LD_A = 528;
__device__ __forceinline__ void gmlp_item(const PCP p, const int l, int item, lptr lds) {
    const int tid = tid_(), lane = tid & 63, wave = __builtin_amdgcn_readfirstlane(tid >> 6);
    const bool sample = item >= 128;
    const size_t row0 = sample ? (size_t)NP + (item - 128) * 128 : (size_t)item * 128;
    { const float4 lg4 = *(const float4*)(p->a_ln_g + l * 256 + lane * 4), lb4 = *(const float4*)(p->a_ln_b + l * 256 + lane * 4);
#pragma unroll 4
      for (int k = 0; k < 16; ++k) {
          const int t = wave * 16 + k;
          const u32x2 raw = *(const u32x2*)(p->proj + (row0 + t) * PP + AV + lane * 4);
          float g[4] = {gelu_(__uint_as_float(raw.x << 16)), gelu_(__uint_as_float(raw.x & 0xffff0000u)), gelu_(__uint_as_float(raw.y << 16)), gelu_(__uint_as_float(raw.y & 0xffff0000u))};
          const float mean = wave_sum(g[0] + g[1] + g[2] + g[3]) * (1.f / 256.f);
          float d2 = 0.f;
#pragma unroll
          for (int e = 0; e < 4; ++e) { g[e] -= mean; d2 += g[e] * g[e]; }
          const float rstd = rsqrtf(wave_sum(d2) * (1.f / 256.f) + EPS);
          const float v0 = g[0] * rstd * lg4.x + lb4.x, v1 = g[1] * rstd * lg4.y + lb4.y, v2 = g[2] * rstd * lg4.z + lb4.z, v3 = g[3] * rstd * lg4.w + lb4.w;
          *(LAS u32x2*)(lds + t * LD_A + lane * 8) = (u32x2){pk2(v0, v1), pk2(v2, v3)};
          if (sample) *(float4*)(p->out + O_AV + ((size_t)l * NS + (row0 - NP) + t) * 256 + lane * 4) = make_float4(v0, v1, v2, v3);
      } }
    __syncthreads();
    const int h = wave >> 1, c0 = 64 * h + 32 * (wave & 1), ql = lane & 15, lg = lane >> 4;
    bf16x8 vf[2][4];
#pragma unroll
    for (int m = 0; m < 2; ++m)
#pragma unroll
        for (int ks = 0; ks < 4; ++ks) vf[m][ks] = frag_tr(lds, LD_A, 32 * ks, c0 + 16 * m, lane);
    const bf16* W = (sample ? p->wsb : p->wpt) + (size_t)(l * 4 + h) * 128 * 128;
    const float* wb = p->a_wb + (l * 4 + h) * 128;
#pragma unroll 1
    for (int i = 0; i < 8; ++i) {
        const int nks = (i >> 1) + 1, t = 16 * i + ql;
        f32x4 acc[2] = {(f32x4){0.f, 0.f, 0.f, 0.f}, (f32x4){0.f, 0.f, 0.f, 0.f}};
#pragma unroll
        for (int ks = 0; ks < 4; ++ks) if (ks < nks) {
            const bf16x8 wf = *(const bf16x8*)(W + t * 128 + 32 * ks + 8 * lg);
            acc[0] = MFMA16(vf[0][ks], wf, acc[0]); acc[1] = MFMA16(vf[1][ks], wf, acc[1]); }
        const float wbv = wb[sample ? (t & 7) : t];
        const size_t row = row0 + t;
#pragma unroll
        for (int m = 0; m < 2; ++m) {
            const int c = c0 + 16 * m + 4 * lg;
            const u32x2 ur = *(const u32x2*)(p->proj + row * PP + AU + c), zr = *(const u32x2*)(p->proj + row * PP + AZ + c);
            const float o0 = gelu_(__uint_as_float(ur.x << 16)) * (acc[m][0] + wbv) * silu_(__uint_as_float(zr.x << 16)), o1 = gelu_(__uint_as_float(ur.x & 0xffff0000u)) * (acc[m][1] + wbv) * silu_(__uint_as_float(zr.x & 0xffff0000u));
            const float o2 = gelu_(__uint_as_float(ur.y << 16)) * (acc[m][2] + wbv) * silu_(__uint_as_float(zr.y << 16)), o3 = gelu_(__uint_as_float(ur.y & 0xffff0000u)) * (acc[m][3] + wbv) * silu_(__uint_as_float(zr.y & 0xffff0000u));
            *(u32x2*)(p->mix + row * DM + c) = (u32x2){pk2(o0, o1), pk2(o2, o3)};
        }
    }
    __syncthreads();
}

constexpr int LD_G = 528, B_CB = 94 * LD_G;
__device__ __forceinline__ void conv_item(const PCP p, const int l, int item, lptr lds) {
    const int tid = tid_(), lane = tid & 63, wave = __builtin_amdgcn_readfirstlane(tid >> 6);
    const bool sample = item >= 256;
    const int nt = sample ? 8 : 64, nrows = nt + 30, b = sample ? 0 : item >> 7, t0 = sample ? 0 : (item & 127) * 64, n = item - 256;
    const size_t row0 = sample ? (size_t)NP + n * 8 : (size_t)b * SEQ + t0;
    LAS float* cb = (LAS float*)(lds + B_CB);
#pragma unroll 2
    for (int k = 0; k < 6; ++k) {
        const int ch = tid + 512 * k, jj = ch >> 5, cc = (ch & 31) * 8;
        if (jj < nrows) {
            float gv[8];
#pragma unroll
            for (int e = 0; e < 8; ++e) gv[e] = 0.f;
            long srow = -1;
            if (!sample) { const int t = t0 - 30 + jj; if (t >= 0) srow = (long)b * SEQ + t; }
            else if (jj >= 30) srow = (long)row0 + jj - 30;
            else { const float* sp = p->st_conv_b + ((size_t)(l * 128 + n) * 30 + jj) * 256 + cc; const float4 a = *(const float4*)sp, bq = *(const float4*)(sp + 4);
                   gv[0] = a.x; gv[1] = a.y; gv[2] = a.z; gv[3] = a.w; gv[4] = bq.x; gv[5] = bq.y; gv[6] = bq.z; gv[7] = bq.w; }
            if (srow >= 0) { float v[8], gg[8]; unpack8(*(const u32x4*)(p->proj + srow * PP + BV + cc), v); unpack8(*(const u32x4*)(p->proj + srow * PP + BG + cc), gg);
#pragma unroll
                for (int e = 0; e < 8; ++e) gv[e] = v[e] * sigmoid_(gg[e]); }
            *(LAS u32x4*)(lds + jj * LD_G + cc * 2) = pack8(gv);
            float* op = nullptr;
            if (sample) { if (jj >= 30) op = p->out + O_CBS + ((size_t)(l * 128 + n) * 8 + (jj - 30)) * 256 + cc; }
            else { const int t = t0 - 30 + jj; if (t >= SEQ - 30) op = p->out + O_CBP + ((size_t)(l * 2 + b) * 30 + (t - (SEQ - 30))) * 256 + cc; }
            if (op) { *(float4*)op = make_float4(gv[0], gv[1], gv[2], gv[3]); *(float4*)(op + 4) = make_float4(gv[4], gv[5], gv[6], gv[7]); }
        }
    }
    __syncthreads();
    { const int c = tid & 255, half = tid >> 8;
      float w[31];
#pragma unroll
      for (int j = 0; j < 31; ++j) w[j] = p->b_conv_w[(size_t)(l * 31 + j) * 256 + c];
      const float cbias = p->b_conv_b[l * 256 + c];
      const int ngrp = sample ? (half == 0 ? 1 : 0) : 4;
#pragma unroll 1
      for (int gi = 0; gi < ngrp; ++gi) {
          const int tg = half * 32 + gi * 8;
          float o[8];
#pragma unroll
          for (int i = 0; i < 8; ++i) o[i] = cbias;
#pragma unroll
          for (int jj = 0; jj < 38; ++jj) {
              const float x = bf2f(*(const LAS bf16*)(lds + (tg + jj) * LD_G + c * 2));
#pragma unroll
              for (int i = 0; i < 8; ++i) if (jj - i >= 0 && jj - i <= 30) o[i] += w[jj - i] * x;
          }
#pragma unroll
          for (int i = 0; i < 8; ++i) cb[(tg + i) * 256 + c] = o[i];
      } }
    __syncthreads();
    { const float4 lg4 = *(const float4*)(p->b_ln_g + l * 256 + lane * 4), lb4 = *(const float4*)(p->b_ln_b + l * 256 + lane * 4);
      const int per = nt >> 3;
#pragma unroll 2
      for (int k = 0; k < per; ++k) {
          const int t = wave * per + k;
          const f32x4 cv = *(const LAS f32x4*)(cb + t * 256 + lane * 4);
          const float mean = wave_sum(cv[0] + cv[1] + cv[2] + cv[3]) * (1.f / 256.f);
          const float d0 = cv[0] - mean, d1 = cv[1] - mean, d2 = cv[2] - mean, d3 = cv[3] - mean;
          const float rstd = rsqrtf(wave_sum(d0 * d0 + d1 * d1 + d2 * d2 + d3 * d3) * (1.f / 256.f) + EPS);
          *(LAS u32x2*)(lds + t * LD_G + lane * 8) = (u32x2){pk2(silu_(d0 * rstd * lg4.x + lb4.x), silu_(d1 * rstd * lg4.y + lb4.y)), pk2(silu_(d2 * rstd * lg4.z + lb4.z), silu_(d3 * rstd * lg4.w + lb4.w))};
      } }
    __syncthreads();
    { const int ql = lane & 15, lg = lane >> 4, nti = sample ? 1 : 4;
      const bf16* pw = p->pwt + (size_t)l * 256 * 256;
      f32x4 acc[2][4];
#pragma unroll
      for (int m = 0; m < 2; ++m)
#pragma unroll
          for (int i = 0; i < 4; ++i) acc[m][i] = (f32x4){0.f, 0.f, 0.f, 0.f};
#pragma unroll 2
      for (int ks = 0; ks < 8; ++ks) {
          const bf16x8 a0 = *(const bf16x8*)(pw + (size_t)(32 * wave + ql) * 256 + 32 * ks + 8 * lg), a1 = *(const bf16x8*)(pw + (size_t)(32 * wave + 16 + ql) * 256 + 32 * ks + 8 * lg);
#pragma unroll
          for (int i = 0; i < 4; ++i) if (i < nti) { const bf16x8 bfr = frag_row(lds, LD_G, 16 * i, 32 * ks, lane); acc[0][i] = MFMA16(a0, bfr, acc[0][i]); acc[1][i] = MFMA16(a1, bfr, acc[1][i]); }
      }
#pragma unroll
      for (int m = 0; m < 2; ++m) {
          const int co = 32 * wave + 16 * m + 4 * lg;
          const float4 pb = *(const float4*)(p->b_pw_b + l * 256 + co);
#pragma unroll
          for (int i = 0; i < 4; ++i) if (i < nti) {
              const int t = 16 * i + ql;
              if (t < nt) { const size_t row = row0 + t; const u32x2 zr = *(const u32x2*)(p->proj + row * PP + BZ + co);
                  *(u32x2*)(p->mix + row * DM + 256 + co) = (u32x2){pk2((acc[m][i][0] + pb.x) * silu_(__uint_as_float(zr.x << 16)), (acc[m][i][1] + pb.y) * silu_(__uint_as_float(zr.x & 0xffff0000u))),
                                                                    pk2((acc[m][i][2] + pb.z) * silu_(__uint_as_float(zr.y << 16)), (acc[m][i][3] + pb.w) * silu_(__uint_as_float(zr.y & 0xffff0000u)))}; }
          }
      } }
    __syncthreads();
}

__device__ __forceinline__ void transpose_item(const float* W, int K, int N, bf16* WT, float* scr, int kb, int nb, int lane) {
    const int k0 = 64 * kb, n0 = 32 * nb;
#pragma unroll 8
    for (int i = 0; i < 32; ++i) { const int kk = 2 * i + (lane >> 5), n = n0 + (lane & 31); scr[kk * 33 + (lane & 31)] = n < N ? W[(size_t)(k0 + kk) * N + n] : 0.f; }
    asm volatile("s_waitcnt lgkmcnt(0)" ::: "memory");
    const int c = lane & 7;
#pragma unroll
    for (int j = 0; j < 4; ++j) { const int n = (lane >> 3) + 8 * j; const float* s = scr + (8 * c) * 33 + n;
        uint4 o; o.x = pk2(s[0 * 33], s[1 * 33]); o.y = pk2(s[2 * 33], s[3 * 33]); o.z = pk2(s[4 * 33], s[5 * 33]); o.w = pk2(s[6 * 33], s[7 * 33]);
        *(uint4*)(WT + (size_t)(n0 + n) * K + k0 + 8 * c) = o; }
    asm volatile("s_waitcnt lgkmcnt(0)" ::: "memory");
}


#define GAS __attribute__((address_space(1)))
typedef GAS unsigned gu32;
#define XB_TMO      128
#define XB_XCNT(j)  (256  + 64 * (j))
#define XB_XSUB(j)  (1280 + 64 * (j))
#define XB_XGEN(j)  (2304 + 64 * (j))
#define XB_TOP      3328
#define XB_TOPGEN   3392
#define XCD_BAR_WORDS 3456
#define XB_SPIN_CAP (1u << 18)

__device__ __forceinline__ unsigned xb_ld(unsigned* p)              { return __hip_atomic_load(p, __ATOMIC_RELAXED, __HIP_MEMORY_SCOPE_AGENT); }
__device__ __forceinline__ unsigned xb_add(unsigned* p, unsigned v) { return __hip_atomic_fetch_add(p, v, __ATOMIC_RELAXED, __HIP_MEMORY_SCOPE_AGENT); }
__device__ __forceinline__ unsigned xb_xcc_id() { return (unsigned)__builtin_amdgcn_s_getreg((3 << 11) | 20) & 0xFu; }
#define XB_SPIN(cond, bar) do { unsigned _sp = 0; while (cond) { __builtin_amdgcn_s_sleep(1); \
    if ((++_sp & 255u) == 0u) { if (xb_ld(&(bar)[XB_TMO])) break; if (_sp > XB_SPIN_CAP) { atomicAdd(&(bar)[XB_TMO], 1u); break; } } } } while (0)

struct XcdBarrier {
    unsigned* bar; unsigned x;
    volatile LAS unsigned* st;
};

__device__ __forceinline__ XcdBarrier xcd_barrier_post(unsigned* bar, volatile LAS unsigned* st) {
    XcdBarrier b; b.bar = bar; b.x = xb_xcc_id(); b.st = st;
    if (threadIdx.x == 0) (void)xb_add(&bar[XB_XCNT(b.x)], 1u);
    return b;
}
__device__ __forceinline__ void xcd_barrier_complete(unsigned* bar, unsigned x, unsigned& nloc, unsigned& nx) {
    const unsigned G = gridDim.x * gridDim.y * gridDim.z;
    unsigned sum, cnt, mine, sp = 0u;
    for (;;) {
        sum = 0u; cnt = 0u; mine = 0u;
#pragma unroll
        for (unsigned j = 0; j < 16; ++j) { const unsigned c = xb_ld(&bar[XB_XCNT(j)]); sum += c; cnt += (c > 0u) ? 1u : 0u; mine = (j == x) ? c : mine; }
        if (sum == G) break;
        __builtin_amdgcn_s_sleep(1);
        if ((++sp & 255u) == 0u) { if (xb_ld(&bar[XB_TMO])) break; if (sp > XB_SPIN_CAP) { atomicAdd(&bar[XB_TMO], 1u); break; } }
    }
    nloc = mine > 0u ? mine : 1u; nx = cnt > 0u ? cnt : 1u;
}

__device__ __forceinline__ void xcd_barrier(const XcdBarrier& b) {
    asm volatile("s_waitcnt vmcnt(0)" ::: "memory");
    __syncthreads();
    if (threadIdx.x == 0) {
        unsigned* bar = b.bar;
        __builtin_amdgcn_s_waitcnt(0);
        unsigned nloc = b.st[0], nx = b.st[1];
        if (nloc == 0u) { xcd_barrier_complete(bar, b.x, nloc, nx); b.st[0] = nloc; b.st[1] = nx; }
        const unsigned old = xb_add(&bar[XB_XSUB(b.x)], 1u);
        const unsigned gen = old / nloc;
        if (old + 1u == (gen + 1u) * nloc) {
            __builtin_amdgcn_fence(__ATOMIC_RELEASE, "agent");
            asm volatile("s_waitcnt vmcnt(0)" ::: "memory");
            const unsigned og = xb_add(&bar[XB_TOP], 1u);
            const unsigned tg = og / nx;
            if (og + 1u == (tg + 1u) * nx) xb_add(&bar[XB_TOPGEN], 1u);
            else XB_SPIN(xb_ld(&bar[XB_TOPGEN]) == tg, bar);
            __builtin_amdgcn_fence(__ATOMIC_ACQUIRE, "agent");
            xb_add(&bar[XB_XGEN(b.x)], 1u);
            asm volatile("s_waitcnt vmcnt(0)" ::: "memory");
        } else {
            XB_SPIN(xb_ld(&bar[XB_XGEN(b.x)]) == gen, bar);
            __builtin_amdgcn_fence(__ATOMIC_ACQUIRE, "agent");
            asm volatile("s_waitcnt vmcnt(0)" ::: "memory");
        }
    }
    __syncthreads();
}

constexpr int LDS_BYTES = 147456, MISC_OFF = LDS_BYTES - 256;
#define GRID_SYNC() xcd_barrier(bar)
__global__ void __launch_bounds__(512, 2) mega(P p_unused) {
    extern __shared__ __attribute__((aligned(16))) unsigned char lds[];
    cg::grid_group grid = cg::this_grid();
    const int tid = tid_(), lane = tid & 63, wave = tid >> 6, G = gridDim.x, bid = blockIdx.x;
    (void)tid;
    volatile LAS unsigned* MISC = (volatile LAS unsigned*)((LAS unsigned char*)lds + MISC_OFF);
    if (tid < 64) MISC[tid] = 0u;
    unsigned* const ctl = (unsigned*)getp()->ctl;
    if (bid == 0) for (int i = tid; i < XCD_BAR_WORDS + 64; i += 512) ctl[i] = 0u;
    { const PCP p = getp(); float* scr = (float*)lds + wave * (64 * 33);
      constexpr int I_IN = (DM / 64) * (PP / 32), I_OUT = (DM / 64) * (DM / 32);
      for (int it = bid * 8 + wave; it < DEPTH * (I_IN + I_OUT); it += G * 8) {
          if (it < DEPTH * I_IN) { const int l = it / I_IN, r = it % I_IN; transpose_item(p->w_in + (size_t)l * DM * IN_DIM, DM, IN_DIM, p->win_t + (size_t)l * PP * DM, scr, r / (PP / 32), r % (PP / 32), lane); }
          else { const int q = it - DEPTH * I_IN, l = q / I_OUT, r = q % I_OUT; transpose_item(p->w_out + (size_t)l * DM * DM, DM, DM, p->wout_t + (size_t)l * DM * DM, scr, r / (DM / 32), r % (DM / 32), lane); }
      }
      constexpr int I_PW = (256 / 64) * (256 / 32);
      for (int it = bid * 8 + wave; it < DEPTH * I_PW; it += G * 8) { const int l = it / I_PW, r = it % I_PW; transpose_item(p->b_pw_w + (size_t)l * 65536, 256, 256, p->pwt + (size_t)l * 65536, scr, r / 8, r % 8, lane); }
      for (int e = bid * 512 + tid; e < DEPTH * 4 * 128 * 128; e += G * 512) {
          const int s_ = e & 127, t = (e >> 7) & 127, lh = e >> 14;
          p->wpt[e] = f2bf(s_ <= t ? p->a_ws[e] : 0.f);
          p->wsb[e] = f2bf(((s_ >> 3) == (t >> 3) && (s_ & 7) <= (t & 7)) ? p->a_ws[(size_t)lh * 16384 + (t & 7) * 128 + (s_ & 7)] : 0.f);
      }
      norm0_phase(p); }
    grid.sync();
    const XcdBarrier bar = xcd_barrier_post(ctl, MISC + 8);
#pragma unroll 1
    for (int l = 0; l < DEPTH; ++l) {
        { const PCP p = getp(); pg8::Gemm g; g.A = p->hb; g.Bt = p->win_t + (size_t)l * PP * DM; g.M = NTOK; g.N = PP; g.K = DM;
          pg8::EpiBf16<0> E; E.O = p->proj; E.ldc = PP; E.bias = nullptr; E.split_cols = 0; E.split_stride = 0; E.scale0 = 1.f;
          pg8::StaticOrder S; S.init(NTOK, PP, G, bid);
          pg8::gemm_phase<pg8::EpiBf16<0>, pg8::StaticOrder, true, true>((PG8_LAS unsigned char*)lds, g, S, E); }
        GRID_SYNC();
        for (int it = bid; it < 136; it += G) gmlp_item(getp(), l, it, (lptr)lds);
        for (int it = bid; it < 384; it += G) conv_item(getp(), l, it, (lptr)lds);
        for (int it = bid; it < 256; it += G) attn_item(getp(), l, it, (lptr)lds);
        for (int it = 256 + bid; it < 512; it += G) mixC_item(getp(), l, it, (float*)lds);
        for (int it = bid; it < 256; it += G) ssd_local_item(getp(), l, it, (lptr)lds);
        for (int it = bid; it < 256; it += G) mixD_sample_item(getp(), l, it, (float*)lds);
        GRID_SYNC();
        scan_phase(getp(), l);
        GRID_SYNC();
        for (int it = bid; it < 256; it += G) ssd_finish_item(getp(), l, it, (lptr)lds);
        GRID_SYNC();
        { const PCP p = getp(); pg8::Gemm g; g.A = p->mix; g.Bt = p->wout_t + (size_t)l * DM * DM; g.M = NTOK; g.N = DM; g.K = DM;
          pg8::EpiF32 E; E.C = p->mixed; E.ldc = DM; E.bias = nullptr;
          pg8::StaticOrder S; S.init(NTOK, DM, G, bid);
          pg8::gemm_phase<pg8::EpiF32, pg8::StaticOrder, true, true>((PG8_LAS unsigned char*)lds, g, S, E); }
        GRID_SYNC();
        post_phase(getp(), l);
        if (l + 1 < DEPTH) GRID_SYNC();
    }
}

extern "C" void kernel_launch(void* const* d_in, const int* in_sizes, int n_in, void* d_out, int out_size, void* d_ws, size_t ws_size, hipStream_t stream) {
    static int grid = 0;
    if (grid == 0) {
        if (n_in != 28 || in_sizes[0] != NP * DM || (size_t)out_size != O_END || ws_size < WS_END) {
            fprintf(stderr, "kernel_launch: unexpected shapes: n_in %d in0 %d out %d (want %zu) ws %zu (want >= %zu)\n", n_in, n_in > 0 ? in_sizes[0] : -1, out_size, (size_t)O_END, ws_size, (size_t)WS_END);
            grid = -1; return; }
        int dev = 0, cus = 0, per_cu = 0;
        if (hipGetDevice(&dev) != hipSuccess || hipDeviceGetAttribute(&cus, hipDeviceAttributeMultiprocessorCount, dev) != hipSuccess) { fprintf(stderr, "kernel_launch: device query failed\n"); grid = -1; return; }
        if (hipFuncSetAttribute((const void*)mega, hipFuncAttributeMaxDynamicSharedMemorySize, LDS_BYTES) != hipSuccess) { fprintf(stderr, "kernel_launch: hipFuncSetAttribute failed\n"); grid = -1; return; }
        if (hipOccupancyMaxActiveBlocksPerMultiprocessor(&per_cu, (const void*)mega, 512, LDS_BYTES) != hipSuccess || per_cu < 1) { fprintf(stderr, "kernel_launch: occupancy query says %d blocks/CU\n", per_cu); grid = -1; return; }
        (void)hipGetLastError();
        grid = cus;
    }
    if (grid < 0) return;
    unsigned char* ws = (unsigned char*)d_ws;
    P p; memset(&p, 0, sizeof p);
    const float** f = (const float**)&p;
    for (int i = 0; i < 28; ++i) f[i] = (const float*)d_in[i];
    p.out = (float*)d_out;
    p.win_t = (bf16*)(ws + WS_WIN); p.wout_t = (bf16*)(ws + WS_WOUT); p.hb = (bf16*)(ws + WS_HB); p.mix = (bf16*)(ws + WS_MIX); p.proj = (bf16*)(ws + WS_PROJ);
    p.mixed = (float*)(ws + WS_MIXED); p.yd = (float*)(ws + WS_YD); p.states = (float*)(ws + WS_ST); p.acum = (float*)(ws + WS_AC); p.cdec = (float*)(ws + WS_CD); p.ctl = (unsigned*)(ws + WS_CTL); p.cs = (bf16*)(ws + WS_CS); p.pwt = (bf16*)(ws + WS_PW); p.wpt = (bf16*)(ws + WS_PW + 512 * 1024); p.wsb = (bf16*)(ws + WS_PW + 1024 * 1024);
    void* args[] = {&p};
    const hipError_t e = hipLaunchCooperativeKernel((const void*)mega, dim3(grid), dim3(512), args, LDS_BYTES, stream);
    if (e != hipSuccess) fprintf(stderr, "kernel_launch: cooperative launch failed: %s (grid %d)\n", hipGetErrorString(e), grid);
}
```
